# Optimizing an MI355X kernel written in HIP

```python
import jax, jax.numpy as jnp
from jax import lax
import numpy as np

D_MODEL = 1024
BATCH = 32
SEQ = 2048
DEPTH = 1

CHUNK = 64
MIX_WIDTH = D_MODEL
POOL_WIDTH = MIX_WIDTH // 2
POOL_WINDOWS = (2, 4, 8, 16)
N_POOL_GROUPS = len(POOL_WINDOWS)
POOL_GROUP = POOL_WIDTH // N_POOL_GROUPS
SB_WIDTH = MIX_WIDTH - POOL_WIDTH
SB_HEAD_DIM = 64
SB_HEADS = SB_WIDTH // SB_HEAD_DIM
Q_BLOCK = 128
IN_WIDTH = 2 * POOL_WIDTH + 4 * SB_WIDTH
EPS = 1e-6

kernel_name = "hybrid_pool_stickbreak_block"


def rmsnorm(x, g):
    x32 = x.astype(jnp.float32)
    y = x32 * lax.rsqrt(jnp.mean(x32 * x32, axis=-1, keepdims=True) + EPS)
    return y.astype(x.dtype) * g


def pool_mixer(u, w_pool, pool_scale):
    b, s, _ = u.shape
    u32 = u.astype(jnp.float32)
    pos = jnp.arange(s)
    outs = []
    for gi, w in enumerate(POOL_WINDOWS):
        ug = u32[..., gi * POOL_GROUP:(gi + 1) * POOL_GROUP]
        cs = jnp.cumsum(ug, axis=1)
        cs_shift = jnp.concatenate(
            [jnp.zeros((b, w, POOL_GROUP), jnp.float32), cs[:, :-w]], axis=1)
        count = jnp.minimum(pos + 1, w).astype(jnp.float32)[None, :, None]
        pooled = (cs - cs_shift) / count - ug
        outs.append(jnp.einsum('bsc,cd->bsd', pooled.astype(u.dtype), w_pool[gi]))
    return jnp.concatenate(outs, axis=-1) * pool_scale


def stick_breaking_attention(q, k, v):
    s_len = q.shape[2]
    inv_sqrt_d = 1.0 / np.sqrt(SB_HEAD_DIM)
    outs = []
    for i in range(s_len // Q_BLOCK):
        n_keys = (i + 1) * Q_BLOCK
        qb = q[:, :, i * Q_BLOCK:(i + 1) * Q_BLOCK]
        kb = k[:, :, :n_keys]
        vb = v[:, :, :n_keys]
        z = jnp.einsum('bhqd,bhkd->bhqk', qb, kb).astype(jnp.float32) * inv_sqrt_d
        qpos = i * Q_BLOCK + jnp.arange(Q_BLOCK)
        kpos = jnp.arange(n_keys)
        mask = kpos[None, :] < qpos[:, None]
        log_beta = jax.nn.log_sigmoid(z)
        log_1mb = jnp.where(mask, jax.nn.log_sigmoid(-z), 0.0)
        tail = lax.cumsum(log_1mb, axis=3, reverse=True) - log_1mb
        a = jnp.where(mask, jnp.exp(log_beta + tail), 0.0)
        outs.append(jnp.einsum('bhqk,bhkd->bhqd', a.astype(vb.dtype), vb))
    return jnp.concatenate(outs, axis=2)


def setup_inputs(seed: int = 0) -> dict:
    key = jax.random.key(seed)
    ks = jax.random.split(key, 10)
    f32 = jnp.float32
    x = jax.random.normal(ks[0], (BATCH, SEQ, D_MODEL), f32)
    c = jax.random.normal(ks[1], (BATCH, D_MODEL), f32)
    w_ada = jax.random.normal(ks[2], (D_MODEL, 3 * D_MODEL), f32) * (0.1 * D_MODEL ** -0.5)
    b_ada = jax.random.normal(ks[3], (3 * D_MODEL,), f32) * 0.01
    g_pre = 1.0 + 0.02 * jax.random.normal(ks[4], (D_MODEL,), f32)
    w_in = jax.random.normal(ks[5], (D_MODEL, IN_WIDTH), f32) * D_MODEL ** -0.5
    w_pool = jax.random.normal(ks[6], (N_POOL_GROUPS, POOL_GROUP, POOL_GROUP), f32) * POOL_GROUP ** -0.5
    pool_scale = 1.0 + 0.02 * jax.random.normal(ks[7], (POOL_WIDTH,), f32)
    w_out = jax.random.normal(ks[8], (MIX_WIDTH, D_MODEL), f32) * MIX_WIDTH ** -0.5
    g_post = 1.0 + 0.02 * jax.random.normal(ks[9], (D_MODEL,), f32)
    return {"x": x, "c": c, "w_ada": w_ada, "b_ada": b_ada, "g_pre": g_pre,
            "w_in": w_in, "w_pool": w_pool, "pool_scale": pool_scale,
            "w_out": w_out, "g_post": g_post}


def reference(x, c, w_ada, b_ada, g_pre, w_in, w_pool, pool_scale, w_out, g_post):
    b, s, _ = x.shape
    mod = jax.nn.silu(c) @ w_ada + b_ada
    shift, scale, gate = jnp.split(mod, 3, axis=-1)
    for _ in range(DEPTH):
        h = rmsnorm(x, g_pre) * (1.0 + scale[:, None, :]) + shift[:, None, :]
        p = h @ w_in
        u, g_pool, q, k, v, g_sb = jnp.split(
            p, np.cumsum([POOL_WIDTH, POOL_WIDTH, SB_WIDTH, SB_WIDTH, SB_WIDTH]), axis=-1)
        y_pool = pool_mixer(u, w_pool, pool_scale) * jax.nn.silu(g_pool)
        to_heads = lambda t: t.reshape(b, s, SB_HEADS, SB_HEAD_DIM).transpose(0, 2, 1, 3)
        o = stick_breaking_attention(to_heads(q), to_heads(k), to_heads(v))
        y_sb = o.transpose(0, 2, 1, 3).reshape(b, s, SB_WIDTH) * jax.nn.silu(g_sb)
        y = jnp.concatenate([y_pool, y_sb], axis=-1) @ w_out
        x = x + gate[:, None, :] * rmsnorm(y, g_post)
    return x
```

```cpp
#include <hip/hip_runtime.h>
#include <hip/hip_cooperative_groups.h>
#include <cstdio>
#include <cstdint>
namespace cg = cooperative_groups;
namespace pg8 {
#define PG8_LAS __attribute__((address_space(3)))
typedef unsigned short bf16_t;
typedef short bf16x8 __attribute__((ext_vector_type(8)));
typedef float f32x4 __attribute__((ext_vector_type(4)));
typedef unsigned u32x4 __attribute__((ext_vector_type(4)));
constexpr int BM = 256, BK = 64, HALF = 128, HTB = HALF * BK * 2  , STAGE_BYTES = 8 * HTB, NXCD = 8, WGM = 8;

__host__ __device__ __forceinline__ int lds_byte(int r, int c) { const int st = (r >> 4) * 2 + (c >> 5), rr = r & 15, cc = c & 31, ob = rr * 64 + cc * 2; return st * 1024 + (ob ^ (((ob >> 9) & 1) << 5)); }
__host__ __device__ __forceinline__ void stage_rc(int b, int& R, int& C) { const int st = b / 1024, sb = b % 1024, swz = sb ^ (((sb >> 9) & 1) << 5); R = (st >> 1) * 16 + swz / 64; C = (st & 1) * 32 + (swz % 64) / 2; }
__host__ __device__ __forceinline__ int perm32(int rho) { const int n = rho >> 4, i = rho & 15; return 8 * (i >> 2) + 4 * n + (i & 3); }

struct Unit { int pm, pn; };
struct Gemm { const bf16_t* A; const bf16_t* Bt; int M, N, K; };

struct StaticOrder {
    int nM, nN, nwg, G, c, wgm;
    __host__ __device__ void init(int M, int N, int G_, int c_, int wgm_ = WGM) { nM = M / BM; nN = N / BM; nwg = nM * nN; G = G_; c = c_; wgm = wgm_; }
    __host__ __device__ bool next(int i, Unit& u) const {
        const long L = (long)i * G + c; if (L >= nwg) return false;
        int wgid = (int)L; { const int q = nwg / NXCD, r = nwg % NXCD, xcd = wgid % NXCD, off = wgid / NXCD; wgid = (xcd < r ? xcd * (q + 1) : r * (q + 1) + (xcd - r) * q) + off; }
        const int nig = wgm * nN, gid = wgid / nig, fm = gid * wgm, gsz = (nM - fm) < wgm ? (nM - fm) : wgm;
        u.pm = fm + ((wgid % nig) % gsz); u.pn = (wgid % nig) / gsz; return true;
    }
    __device__ __forceinline__ void a_ready(const Unit&) const {}
    __device__ __forceinline__ void done(const Unit&) const {}
};

__device__ __forceinline__ unsigned cvt_pk_bf16(float lo, float hi) { unsigned r; asm volatile("v_cvt_pk_bf16_f32 %0, %1, %2" : "=v"(r) : "v"(lo), "v"(hi)); return r; }
typedef unsigned u32x2 __attribute__((ext_vector_type(2)));
constexpr float QSCALE = 0.125f * 1.4426950408889634f;
struct EpiP {
    static constexpr bool PERM = true, AFTER_DRAIN = false;
    bf16_t* O;
    __device__ __forceinline__ void operator()(const f32x4 (&acc)[2][2][4][2], const Unit& u, int wr, int wc, int fr, int fq) const {
        const int blk = u.pn >> 1, b = u.pm >> 3, t0 = (u.pm & 7) * BM + wr * 64 + fr;
        const float sc = (blk == 2) ? QSCALE : 1.f;
        bf16_t* blkp = O + (size_t)blk * (65536u * 512u);
#pragma unroll
        for (int bj = 0; bj < 2; ++bj) {
            const int c512 = (u.pn & 1) * BM + bj * HALF + wc * 32 + 8 * fq;
            bf16_t* cp = (blk < 2) ? blkp + ((size_t)(b * 4 + (c512 >> 7)) * 2048) * 128 + (c512 & 127) : blkp + ((size_t)(b * 8 + (c512 >> 6)) * 2048) * 64 + (c512 & 63);
            const int rs = (blk < 2) ? 128 : 64;
#pragma unroll
            for (int ai = 0; ai < 2; ++ai)
#pragma unroll
                for (int m = 0; m < 4; ++m) { const f32x4 v0 = acc[ai][bj][m][0] * sc, v1 = acc[ai][bj][m][1] * sc;
                    u32x4 w; w.x = cvt_pk_bf16(v0[0], v0[1]); w.y = cvt_pk_bf16(v0[2], v0[3]); w.z = cvt_pk_bf16(v1[0], v1[1]); w.w = cvt_pk_bf16(v1[2], v1[3]);
                    *(u32x4*)(cp + (size_t)(t0 + ai * HALF + m * 16) * rs) = w; }
        }
    }
};
struct EpiY {
    static constexpr bool PERM = true, AFTER_DRAIN = false;
    bf16_t* O; int ldc; float* ssq;
    __device__ __forceinline__ void operator()(const f32x4 (&acc)[2][2][4][2], const Unit& u, int wr, int wc, int fr, int fq) const {
        const int row0 = u.pm * BM + wr * 64 + fr, col0 = u.pn * BM + wc * 32 + 8 * fq;
#pragma unroll
        for (int ai = 0; ai < 2; ++ai)
#pragma unroll
            for (int m = 0; m < 4; ++m) { const int row = row0 + ai * HALF + m * 16; bf16_t* rowp = O + (size_t)row * ldc + col0; float s = 0.f;
#pragma unroll
                for (int bj = 0; bj < 2; ++bj) { const f32x4 v0 = acc[ai][bj][m][0], v1 = acc[ai][bj][m][1];
                    s += (v0[0] * v0[0] + v0[1] * v0[1]) + (v0[2] * v0[2] + v0[3] * v0[3]) + (v1[0] * v1[0] + v1[1] * v1[1]) + (v1[2] * v1[2] + v1[3] * v1[3]);
                    u32x4 w; w.x = cvt_pk_bf16(v0[0], v0[1]); w.y = cvt_pk_bf16(v0[2], v0[3]); w.z = cvt_pk_bf16(v1[0], v1[1]); w.w = cvt_pk_bf16(v1[2], v1[3]);
                    *(u32x4*)(rowp + bj * HALF) = w; }
                s += __shfl_xor(s, 16); s += __shfl_xor(s, 32);
                if (fq == 0) ssq[(size_t)row * 16 + u.pn * 4 + wc] = s; }
    }
};
template <class Epi, class Sched, bool ALIGN_EPI = false, bool SP2 = false>
__device__ __forceinline__ void gemm_phase(PG8_LAS unsigned char* lds, const Gemm g, const Sched& S, const Epi& E) {
    const int tid = threadIdx.x, wid = __builtin_amdgcn_readfirstlane(tid >> 6), lane = tid & 63, wr = wid >> 2, wc = wid & 3, fr = lane & 15, fq = lane >> 4;
    const int K = g.K, nt = K / BK;
    unsigned voffA[2], voffB[2];
#pragma unroll
    for (int i = 0; i < 2; ++i) { int R, C; stage_rc(tid * 16 + i * 8192, R, C); const int Rb = Epi::PERM ? ((R & ~31) + perm32(R & 31)) : R;
        voffA[i] = (unsigned)(R * K + C) * 2u; voffB[i] = (unsigned)(Rb * K + C) * 2u; }
    const size_t kstep = (size_t)(BK * 2);
    const size_t hstep = (size_t)HALF * K * 2;
    const size_t tstep = 2 * hstep;
    const unsigned ldsw = (unsigned)wid * 1024u;
    const int aoff = lds_byte(wr * 64 + fr, fq * 8), boff = lds_byte(wc * 32 + fr, fq * 8);
#define PG8_SA(b, h) (((b) * 2 + (h)) * HTB)
#define PG8_SB(b, h) ((4 + (b) * 2 + (h)) * HTB)
#define PG8_STAGE(bufoff, gbase, voff) do { _Pragma("unroll") for (int _i = 0; _i < 2; ++_i) \
        __builtin_amdgcn_global_load_lds((const unsigned*)((const char*)(gbase) + (voff)[_i]), (PG8_LAS unsigned*)(lds + (bufoff) + ldsw + _i * 8192), 16, 0, 0); } while (0)
#define PG8_LDA(dst, b, h) do { _Pragma("unroll") for (int m = 0; m < 4; ++m) _Pragma("unroll") for (int k = 0; k < 2; ++k) dst[m][k] = *(const PG8_LAS bf16x8*)(lds + PG8_SA(b, h) + aoff + m * 2048 + k * 1024); } while (0)
#define PG8_LDB(dst, b, h) do { _Pragma("unroll") for (int n = 0; n < 2; ++n) _Pragma("unroll") for (int k = 0; k < 2; ++k) dst[n][k] = *(const PG8_LAS bf16x8*)(lds + PG8_SB(b, h) + boff + n * 2048 + k * 1024); } while (0)
#define PG8_MMA(ai, bj, At, Bt) do { __builtin_amdgcn_s_setprio(1); _Pragma("unroll") for (int m = 0; m < 4; ++m) _Pragma("unroll") for (int n = 0; n < 2; ++n) _Pragma("unroll") for (int k = 0; k < 2; ++k) \
        acc[ai][bj][m][n] = __builtin_amdgcn_mfma_f32_16x16x32_bf16(Bt[n][k], At[m][k], acc[ai][bj][m][n], 0, 0, 0); __builtin_amdgcn_s_setprio(0); } while (0)
#define PG8_WAIT_V(n) asm volatile("s_waitcnt vmcnt(" #n ")" ::: "memory")
#define PG8_WAIT_L(n) asm volatile("s_waitcnt lgkmcnt(" #n ")" ::: "memory")
#define PG8_BAR __builtin_amdgcn_s_barrier()
#define PG8_SCHED __builtin_amdgcn_sched_barrier(0)
    Unit cur, nxt; int ui = 0;
    if (!S.next(0, cur)) return;
    f32x4 acc[2][2][4][2];
#pragma unroll
    for (int a = 0; a < 2; ++a)
#pragma unroll
        for (int b = 0; b < 2; ++b)
#pragma unroll
            for (int m = 0; m < 4; ++m)
#pragma unroll
                for (int n = 0; n < 2; ++n) acc[a][b][m][n] = (f32x4){0.f, 0.f, 0.f, 0.f};
    bf16x8 At[4][2], B0[2][2], B1[2][2];
    const char* cA = (const char*)g.A + (size_t)cur.pm * tstep; const char* cB = (const char*)g.Bt + (size_t)cur.pn * tstep;
    S.a_ready(cur);
    if constexpr (SP2) {
        PG8_STAGE(PG8_SB(0, 0), cB, voffB); PG8_STAGE(PG8_SB(0, 1), cB + hstep, voffB); PG8_STAGE(PG8_SA(0, 0), cA, voffA); PG8_STAGE(PG8_SA(0, 1), cA + hstep, voffA);
        if (wr == 1) PG8_BAR;
        PG8_WAIT_V(2); PG8_BAR;
        PG8_STAGE(PG8_SB(1, 0), cB + kstep, voffB); PG8_STAGE(PG8_SA(1, 0), cA + kstep, voffA); PG8_STAGE(PG8_SB(1, 1), cB + hstep + kstep, voffB);
        PG8_WAIT_V(6); PG8_BAR;
    } else {
        PG8_STAGE(PG8_SB(0, 0), cB, voffB); PG8_STAGE(PG8_SA(0, 0), cA, voffA); PG8_STAGE(PG8_SB(0, 1), cB + hstep, voffB); PG8_STAGE(PG8_SA(0, 1), cA + hstep, voffA);
        if (wr == 1) PG8_BAR;
        PG8_WAIT_V(4); PG8_BAR;
        PG8_STAGE(PG8_SB(1, 0), cB + kstep, voffB); PG8_STAGE(PG8_SA(1, 0), cA + kstep, voffA); PG8_STAGE(PG8_SB(1, 1), cB + hstep + kstep, voffB);
        PG8_WAIT_V(6); PG8_BAR;
    }
    for (;;) {
        const bool has_next = S.next(ui + 1, nxt);
        const char* nA = has_next ? (const char*)g.A + (size_t)nxt.pm * tstep : cA; const char* nB = has_next ? (const char*)g.Bt + (size_t)nxt.pn * tstep : cB;
        for (int t = 0; t < nt; t += 2) {
            const bool last = (t == nt - 2);
            const char* a1 = cA + (size_t)(t + 1) * kstep;
            const char* a2 = last ? nA : cA + (size_t)(t + 2) * kstep; const char* b2 = last ? nB : cB + (size_t)(t + 2) * kstep;
            const char* a3 = a2 + kstep; const char* b3 = b2 + kstep;
            if (last && has_next) S.a_ready(nxt);
            if constexpr (SP2) {
            PG8_LDB(B0, 0, 0); PG8_LDB(B1, 0, 1); PG8_SCHED; PG8_LDA(At, 0, 0); PG8_STAGE(PG8_SA(1, 1), a1 + hstep, voffA);
            PG8_WAIT_V(8); PG8_WAIT_L(0); PG8_BAR; PG8_MMA(0, 0, At, B0); PG8_MMA(0, 1, At, B1); PG8_BAR; PG8_SCHED;
            PG8_LDA(At, 0, 1); PG8_STAGE(PG8_SB(0, 0), b2, voffB); PG8_STAGE(PG8_SB(0, 1), b2 + hstep, voffB); PG8_STAGE(PG8_SA(0, 0), a2, voffA);
            PG8_WAIT_V(8); PG8_WAIT_L(0); PG8_BAR; PG8_MMA(1, 0, At, B0); PG8_MMA(1, 1, At, B1); PG8_BAR; PG8_SCHED;
            PG8_LDB(B0, 1, 0); PG8_LDB(B1, 1, 1); PG8_SCHED; PG8_LDA(At, 1, 0); PG8_STAGE(PG8_SA(0, 1), a2 + hstep, voffA);
            PG8_WAIT_V(8); PG8_WAIT_L(0); PG8_BAR; PG8_MMA(0, 0, At, B0); PG8_MMA(0, 1, At, B1); PG8_BAR; PG8_SCHED;
            PG8_LDA(At, 1, 1); PG8_STAGE(PG8_SB(1, 0), b3, voffB); PG8_STAGE(PG8_SB(1, 1), b3 + hstep, voffB); PG8_STAGE(PG8_SA(1, 0), a3, voffA);
            PG8_WAIT_V(8); PG8_WAIT_L(0); PG8_BAR; PG8_MMA(1, 0, At, B0); PG8_MMA(1, 1, At, B1); PG8_BAR; PG8_SCHED;
            } else {
            PG8_LDB(B0, 0, 0); PG8_SCHED; PG8_LDA(At, 0, 0); PG8_STAGE(PG8_SA(1, 1), a1 + hstep, voffA);
            PG8_WAIT_L(8); PG8_BAR; PG8_WAIT_L(0); PG8_MMA(0, 0, At, B0); PG8_BAR; PG8_SCHED;
            PG8_LDB(B1, 0, 1); PG8_STAGE(PG8_SB(0, 0), b2, voffB);
            PG8_BAR; PG8_WAIT_L(0); PG8_MMA(0, 1, At, B1); PG8_BAR;
            PG8_LDA(At, 0, 1); PG8_STAGE(PG8_SA(0, 0), a2, voffA);
            PG8_BAR; PG8_WAIT_L(0); PG8_MMA(1, 0, At, B0); PG8_BAR; PG8_SCHED;
            PG8_STAGE(PG8_SB(0, 1), b2 + hstep, voffB);
            PG8_WAIT_V(6); PG8_BAR; PG8_MMA(1, 1, At, B1); PG8_BAR;
            PG8_LDB(B0, 1, 0); PG8_SCHED; PG8_LDA(At, 1, 0); PG8_STAGE(PG8_SA(0, 1), a2 + hstep, voffA);
            PG8_WAIT_L(8); PG8_BAR; PG8_WAIT_L(0); PG8_MMA(0, 0, At, B0); PG8_BAR; PG8_SCHED;
            PG8_LDB(B1, 1, 1); PG8_STAGE(PG8_SB(1, 0), b3, voffB);
            PG8_BAR; PG8_WAIT_L(0); PG8_MMA(0, 1, At, B1); PG8_BAR;
            PG8_LDA(At, 1, 1); PG8_STAGE(PG8_SA(1, 0), a3, voffA);
            PG8_BAR; PG8_WAIT_L(0); PG8_MMA(1, 0, At, B0); PG8_BAR; PG8_SCHED;
            PG8_STAGE(PG8_SB(1, 1), b3 + hstep, voffB);
            PG8_WAIT_V(6); PG8_BAR; PG8_MMA(1, 1, At, B1); PG8_BAR;
            }
        }
        if constexpr (ALIGN_EPI) { if (wr == 0) PG8_BAR; }
        if constexpr (!Epi::AFTER_DRAIN) { E(acc, cur, wr, wc, fr, fq); S.done(cur); }
        if (!has_next) break;
#pragma unroll
        for (int a = 0; a < 2; ++a)
#pragma unroll
            for (int b = 0; b < 2; ++b)
#pragma unroll
                for (int m = 0; m < 4; ++m)
#pragma unroll
                    for (int n = 0; n < 2; ++n) acc[a][b][m][n] = (f32x4){0.f, 0.f, 0.f, 0.f};
        cur = nxt; cA = nA; cB = nB; ++ui;
        if constexpr (ALIGN_EPI) { if (wr == 1) PG8_BAR; }
    }
    PG8_WAIT_V(0);
    if constexpr (!ALIGN_EPI) { if (wr == 0) PG8_BAR; }
    PG8_BAR;
    if constexpr (Epi::AFTER_DRAIN) { E.fused(acc, cur, wr, wc, fr, fq, lds, wid, lane); S.done(cur); }
#undef PG8_SA
#undef PG8_SB
#undef PG8_STAGE
#undef PG8_LDA
#undef PG8_LDB
#undef PG8_MMA
#undef PG8_WAIT_V
#undef PG8_WAIT_L
#undef PG8_BAR
#undef PG8_SCHED
}
}
constexpr int BATCH = 32, SEQ = 2048, D = 1024, M = BATCH * SEQ, NIN = 3072, NH = 8, HD = 64;
constexpr size_t PBLK = (size_t)65536 * 512;
constexpr size_t B_U = 0, B_GP = PBLK, B_Q = 2 * PBLK, B_K = 3 * PBLK, B_V = 4 * PBLK, B_GS = 5 * PBLK;
constexpr float EPS = 1e-6f, LOG2E = 1.4426950408889634f;
constexpr int NWAVES = 8, NTHREADS = NWAVES * 64;
#ifndef WGM_IN
#define WGM_IN 24
#endif
#ifndef WGM_OUT
#define WGM_OUT 16
#endif
constexpr int WGM_IN_ = WGM_IN, WGM_OUT_ = WGM_OUT;
constexpr size_t MiB = 1u << 20;
constexpr size_t WS_MOD = 0;
constexpr size_t WS_WIN = 1 * MiB;
constexpr size_t WS_WOUT = 8 * MiB;
constexpr size_t WS_SSQ = 12 * MiB;
constexpr size_t WS_H = 16 * MiB;
constexpr size_t WS_P = 144 * MiB;
constexpr size_t WS_YO = 528 * MiB;
constexpr size_t WS_END = 656 * MiB;
constexpr size_t WS_BAR = 11 * MiB;
constexpr int RING_BYTES = 131072, LDS_BYTES = 147456, LDS_BARST = RING_BYTES + 8192;

#define GAS __attribute__((address_space(1)))
#define LAS __attribute__((address_space(3)))
typedef unsigned short bf16;
typedef unsigned v4u __attribute__((ext_vector_type(4)));
typedef unsigned v2u __attribute__((ext_vector_type(2)));
typedef float f32x4 __attribute__((ext_vector_type(4)));
typedef float f32x16 __attribute__((ext_vector_type(16)));
typedef short bf16x8 __attribute__((ext_vector_type(8)));
typedef short s16x4 __attribute__((ext_vector_type(4)));
#define LDS_WAIT() asm volatile("s_waitcnt lgkmcnt(0)" ::: "memory")
__device__ __forceinline__ unsigned f2bf(float f) { unsigned u = __builtin_bit_cast(unsigned, f); return (u + 0x7fffu + ((u >> 16) & 1u)) >> 16; }
__device__ __forceinline__ unsigned pk2(float lo, float hi) { return pg8::cvt_pk_bf16(lo, hi); }
__device__ __forceinline__ float bflo(unsigned w) { return __builtin_bit_cast(float, w << 16); }
__device__ __forceinline__ float bfhi(unsigned w) { return __builtin_bit_cast(float, w & 0xffff0000u); }
__device__ __forceinline__ float silu_f(float g) { return g * __builtin_amdgcn_rcpf(1.0f + __builtin_amdgcn_exp2f(-g * LOG2E)); }
__device__ __forceinline__ float wave_sum(float v) {
#pragma unroll
    for (int o = 1; o < 64; o <<= 1) v += __shfl_xor(v, o);
    return v;
}

#define XB_TMO      128
#define XB_XCNT(j)  (256  + 64 * (j))
#define XB_XSUB(j)  (1280 + 64 * (j))
#define XB_XGEN(j)  (2304 + 64 * (j))
#define XB_TOP      3328
#define XB_TOPGEN   3392
#define XCD_BAR_WORDS 3456
#define XB_SPIN_CAP (1u << 18)

__device__ __forceinline__ unsigned xb_ld(unsigned* p)              { return __hip_atomic_load(p, __ATOMIC_RELAXED, __HIP_MEMORY_SCOPE_AGENT); }
__device__ __forceinline__ unsigned xb_add(unsigned* p, unsigned v) { return __hip_atomic_fetch_add(p, v, __ATOMIC_RELAXED, __HIP_MEMORY_SCOPE_AGENT); }
__device__ __forceinline__ unsigned xb_xcc_id() { return (unsigned)__builtin_amdgcn_s_getreg((3 << 11) | 20) & 0xFu; }
#define XB_SPIN(cond, bar) do { unsigned _sp = 0; while (cond) { __builtin_amdgcn_s_sleep(1); \
    if ((++_sp & 255u) == 0u) { if (xb_ld(&(bar)[XB_TMO])) break; if (_sp > XB_SPIN_CAP) { atomicAdd(&(bar)[XB_TMO], 1u); break; } } } } while (0)

struct XcdBarrier {
    unsigned* bar; unsigned x;
    volatile LAS unsigned* st;
};

__device__ __forceinline__ XcdBarrier xcd_barrier_post(unsigned* bar, volatile LAS unsigned* st) {
    XcdBarrier b; b.bar = bar; b.x = xb_xcc_id(); b.st = st;
    if (threadIdx.x == 0) (void)xb_add(&bar[XB_XCNT(b.x)], 1u);
    return b;
}
__device__ __forceinline__ void xcd_barrier_complete(unsigned* bar, unsigned x, unsigned& nloc, unsigned& nx) {
    const unsigned G = gridDim.x * gridDim.y * gridDim.z;
    unsigned sum, cnt, mine, sp = 0u;
    for (;;) {
        sum = 0u; cnt = 0u; mine = 0u;
#pragma unroll
        for (unsigned j = 0; j < 16; ++j) { const unsigned c = xb_ld(&bar[XB_XCNT(j)]); sum += c; cnt += (c > 0u) ? 1u : 0u; mine = (j == x) ? c : mine; }
        if (sum == G) break;
        __builtin_amdgcn_s_sleep(1);
        if ((++sp & 255u) == 0u) { if (xb_ld(&bar[XB_TMO])) break; if (sp > XB_SPIN_CAP) { atomicAdd(&bar[XB_TMO], 1u); break; } }
    }
    nloc = mine > 0u ? mine : 1u; nx = cnt > 0u ? cnt : 1u;
}

__device__ __forceinline__ void xcd_barrier(const XcdBarrier& b) {
    asm volatile("s_waitcnt vmcnt(0)" ::: "memory");
    __syncthreads();
    if (threadIdx.x == 0) {
        unsigned* bar = b.bar;
        __builtin_amdgcn_s_waitcnt(0);
        unsigned nloc = b.st[0], nx = b.st[1];
        if (nloc == 0u) { xcd_barrier_complete(bar, b.x, nloc, nx); b.st[0] = nloc; b.st[1] = nx; }
        const unsigned old = xb_add(&bar[XB_XSUB(b.x)], 1u);
        const unsigned gen = old / nloc;
        if (old + 1u == (gen + 1u) * nloc) {
            __builtin_amdgcn_fence(__ATOMIC_RELEASE, "agent");
            asm volatile("s_waitcnt vmcnt(0)" ::: "memory");
            const unsigned og = xb_add(&bar[XB_TOP], 1u);
            const unsigned tg = og / nx;
            if (og + 1u == (tg + 1u) * nx) xb_add(&bar[XB_TOPGEN], 1u);
            else XB_SPIN(xb_ld(&bar[XB_TOPGEN]) == tg, bar);
            __builtin_amdgcn_fence(__ATOMIC_ACQUIRE, "agent");
            xb_add(&bar[XB_XGEN(b.x)], 1u);
            asm volatile("s_waitcnt vmcnt(0)" ::: "memory");
        } else {
            XB_SPIN(xb_ld(&bar[XB_XGEN(b.x)]) == gen, bar);
            __builtin_amdgcn_fence(__ATOMIC_ACQUIRE, "agent");
            asm volatile("s_waitcnt vmcnt(0)" ::: "memory");
        }
    }
    __syncthreads();
}

struct Args { const float* in[10]; float* out; unsigned char* ws; int ph_lo, ph_hi; };

__device__ __forceinline__ void p0_transpose_item(const float* W, int K, int N, bf16* WT, LAS float* scr, int item, int lane) {
    const int nblk = N / 32, kb = item / nblk, nb = item % nblk, k0 = 64 * kb, n0 = 32 * nb;
    { float tv[32];
#pragma unroll
      for (int i = 0; i < 32; ++i) { const int kk = 2 * i + (lane >> 5); tv[i] = W[(size_t)(k0 + kk) * N + n0 + (lane & 31)]; }
      asm volatile("" ::: "memory");
#pragma unroll
      for (int i = 0; i < 32; ++i) { const int kk = 2 * i + (lane >> 5); scr[kk * 33 + (lane & 31)] = tv[i]; } }
    LDS_WAIT();
    const int c = lane & 7;
#pragma unroll
    for (int j = 0; j < 4; ++j) { const int n = (lane >> 3) + 8 * j; const LAS float* s = scr + (8 * c) * 33 + n;
        v4u o; o.x = pk2(s[0 * 33], s[1 * 33]); o.y = pk2(s[2 * 33], s[3 * 33]); o.z = pk2(s[4 * 33], s[5 * 33]); o.w = pk2(s[6 * 33], s[7 * 33]);
        *(v4u*)(WT + (size_t)(n0 + n) * K + k0 + 8 * c) = o; }
    LDS_WAIT();
}
__device__ __forceinline__ void p0_fold_item(const float* w_in, const float* w_pool, bf16* Win_t, LAS unsigned char* lds, int item, int tid) {
    const int g = item & 3, k0 = (item >> 2) * 16;
    LAS float* As = (LAS float*)lds;
    LAS float* Bs = (LAS float*)(lds + 8192);
    { f32x4 av, bv[8];
      { const int r = tid >> 5, c4 = tid & 31; av = *(const f32x4*)(w_in + (size_t)(k0 + r) * NIN + g * 128 + c4 * 4); }
#pragma unroll
      for (int i = 0; i < 8; ++i) { const int e = tid + i * NTHREADS, r = e >> 5, c4 = e & 31; bv[i] = *(const f32x4*)(w_pool + (size_t)g * 16384 + (size_t)r * 128 + c4 * 4); }
      { const int r = tid >> 5, c4 = tid & 31; *(LAS f32x4*)(As + r * 128 + c4 * 4) = av; }
#pragma unroll
      for (int i = 0; i < 8; ++i) { const int e = tid + i * NTHREADS, r = e >> 5, c4 = e & 31; *(LAS f32x4*)(Bs + r * 128 + c4 * 4) = bv[i]; } }
    __syncthreads();
    const int n = tid & 127, kq = tid >> 7;
    float acc[4] = {0.f, 0.f, 0.f, 0.f};
#pragma unroll 4
    for (int c = 0; c < 128; c += 4) {
        const float b0 = Bs[(c + 0) * 128 + n], b1 = Bs[(c + 1) * 128 + n], b2 = Bs[(c + 2) * 128 + n], b3 = Bs[(c + 3) * 128 + n];
#pragma unroll
        for (int i = 0; i < 4; ++i) { const f32x4 a = *(const LAS f32x4*)(As + (kq * 4 + i) * 128 + c); acc[i] += (a[0] * b0 + a[1] * b1) + (a[2] * b2 + a[3] * b3); }
    }
    v2u o; o.x = pk2(acc[0], acc[1]); o.y = pk2(acc[2], acc[3]);
    *(v2u*)(Win_t + (size_t)(g * 128 + n) * D + k0 + kq * 4) = o;
    __syncthreads();
}

__device__ __forceinline__ void p0_adaln_item(const float* c, const float* w_ada, const float* b_ada, float* mod, LAS unsigned char* lds, int item, int tid) {
    const int lane = tid & 63, wave = tid >> 6;
    const int jb = item >> 2, bg = item & 3, j0 = jb * 64, b0 = bg * 8;
    LAS float* sT = (LAS float*)lds;
    LAS float* part = (LAS float*)(lds + 32768);
    { float cv[16];
#pragma unroll
      for (int i = 0; i < 16; ++i) { const int e = tid + i * NTHREADS; cv[i] = c[(size_t)(b0 + (e >> 10)) * D + (e & 1023)]; }
#pragma unroll
      for (int i = 0; i < 16; ++i) { const int e = tid + i * NTHREADS, b = e >> 10, k = e & 1023; const float v = cv[i]; sT[k * 8 + b] = v * __builtin_amdgcn_rcpf(1.0f + __expf(-v)); } }
    __syncthreads();
    float acc[8];
#pragma unroll
    for (int i = 0; i < 8; ++i) acc[i] = 0.f;
    const float* wp = w_ada + (size_t)(wave * 128) * NIN + j0 + lane;
#pragma unroll 1
    for (int k0 = 0; k0 < 128; k0 += 16) {
        float wv[16];
#pragma unroll
        for (int j = 0; j < 16; ++j) wv[j] = wp[(size_t)(k0 + j) * NIN];
        asm volatile("" ::: "memory");
#pragma unroll
        for (int j = 0; j < 16; ++j) {
            const float w = wv[j];
            const f32x4 s0 = *(const LAS f32x4*)(sT + (wave * 128 + k0 + j) * 8), s1 = *(const LAS f32x4*)(sT + (wave * 128 + k0 + j) * 8 + 4);
            acc[0] += s0[0] * w; acc[1] += s0[1] * w; acc[2] += s0[2] * w; acc[3] += s0[3] * w;
            acc[4] += s1[0] * w; acc[5] += s1[1] * w; acc[6] += s1[2] * w; acc[7] += s1[3] * w;
        }
    }
#pragma unroll
    for (int i = 0; i < 8; ++i) part[(wave * 8 + i) * 64 + lane] = acc[i];
    __syncthreads();
    { const int b = tid >> 6; float s = b_ada[j0 + lane];
#pragma unroll
      for (int w = 0; w < 8; ++w) s += part[(w * 8 + b) * 64 + lane];
      mod[(size_t)(b0 + b) * NIN + j0 + lane] = s; }
    __syncthreads();
}

__device__ __forceinline__ void p1_rows(const float* x, const float* g_pre, const float* mod, bf16* H, int gw, int ngw, int lane) {
    constexpr int RPW = 32, PF = 4;
    for (int it = gw; it < M / RPW; it += ngw) {
        const int row0 = it * RPW, b = row0 / SEQ;
        f32x4 gm[4], sh[4];
#pragma unroll
        for (int j = 0; j < 4; ++j) { const int k = 8 * lane + 512 * (j >> 1) + 4 * (j & 1);
            const f32x4 g = *(const f32x4*)(g_pre + k), sc = *(const f32x4*)(mod + (size_t)b * NIN + 1024 + k);
            gm[j] = g * (sc + 1.0f); sh[j] = *(const f32x4*)(mod + (size_t)b * NIN + k); }
        const float* xb = x + (size_t)row0 * D + 8 * lane;
        bf16* ob = H + (size_t)row0 * D + 8 * lane;
        f32x4 buf[PF][4];
#pragma unroll
        for (int p = 0; p < PF; ++p)
#pragma unroll
            for (int j = 0; j < 4; ++j) buf[p][j] = __builtin_nontemporal_load((const f32x4*)(xb + (size_t)p * D + 512 * (j >> 1) + 4 * (j & 1)));
#pragma unroll 1
        for (int r = 0; r < RPW; r += PF) {
#pragma unroll
            for (int p = 0; p < PF; ++p) {
                f32x4 v[4]; float s = 0.f;
#pragma unroll
                for (int j = 0; j < 4; ++j) { v[j] = buf[p][j]; s += (v[j][0] * v[j][0] + v[j][1] * v[j][1]) + (v[j][2] * v[j][2] + v[j][3] * v[j][3]); }
                { const int rn = (r + p + PF < RPW) ? (r + p + PF) : (RPW - 1);
#pragma unroll
                    for (int j = 0; j < 4; ++j) buf[p][j] = __builtin_nontemporal_load((const f32x4*)(xb + (size_t)rn * D + 512 * (j >> 1) + 4 * (j & 1))); }
                const float rstd = 1.0f / sqrtf(wave_sum(s) * (1.0f / D) + EPS);
                bf16* op = ob + (size_t)(r + p) * D;
#pragma unroll
                for (int j = 0; j < 2; ++j) { const f32x4 h0 = (v[2 * j] * rstd) * gm[2 * j] + sh[2 * j], h1 = (v[2 * j + 1] * rstd) * gm[2 * j + 1] + sh[2 * j + 1];
                    v4u o; o.x = pk2(h0[0], h0[1]); o.y = pk2(h0[2], h0[3]); o.z = pk2(h1[0], h1[1]); o.w = pk2(h1[2], h1[3]); *(v4u*)(op + 512 * j) = o; }
            }
        }
    }
}

__device__ __forceinline__ void add8(float (&a)[8], const v4u c) {
    a[0] += bflo(c.x); a[1] += bfhi(c.x); a[2] += bflo(c.y); a[3] += bfhi(c.y); a[4] += bflo(c.z); a[5] += bfhi(c.z); a[6] += bflo(c.w); a[7] += bfhi(c.w);
}
__device__ __forceinline__ void unpack8(float (&f)[8], const v4u c) { f[0] = bflo(c.x); f[1] = bfhi(c.x); f[2] = bflo(c.y); f[3] = bfhi(c.y); f[4] = bflo(c.z); f[5] = bfhi(c.z); f[6] = bflo(c.w); f[7] = bfhi(c.w); }
template <int W> __device__ __forceinline__ void pool_item(const bf16* P, const float* pool_scale, bf16* Y, int tt, int gi, int lane) {
    const int c16 = lane & 15, tg = lane >> 4;
    const int row0 = tt * 32 + tg * 8, tf = row0 & (SEQ - 1);
    const size_t prow = ((size_t)((row0 >> 11) * 4 + gi) * SEQ + tf) * 128 + c16 * 8;
    const bf16* up = P + B_U + prow; const bf16* gp = P + B_GP + prow;
    asm volatile("" : "+v"(up), "+v"(gp));
    v4u u[W + 7], g[8];
#pragma unroll
    for (int r = 0; r < W + 7; ++r) { const int dr = r - (W - 1); const bool ok = (tf + dr >= 0); u[r] = *(const v4u*)(up + (ptrdiff_t)(ok ? dr : 0) * 128); if (!ok) u[r] = (v4u){0u, 0u, 0u, 0u}; }
#pragma unroll
    for (int i = 0; i < 8; ++i) g[i] = *(const v4u*)(gp + (size_t)i * 128);
    const f32x4 ps0 = *(const f32x4*)(pool_scale + gi * 128 + c16 * 8), ps1 = *(const f32x4*)(pool_scale + gi * 128 + c16 * 8 + 4);
    const float ps[8] = {ps0[0], ps0[1], ps0[2], ps0[3], ps1[0], ps1[1], ps1[2], ps1[3]};
    float S[8];
#pragma unroll
    for (int e = 0; e < 8; ++e) S[e] = 0.f;
#pragma unroll
    for (int r = 0; r < W - 1; ++r) { float f[8]; unpack8(f, u[r]);
#pragma unroll
        for (int e = 0; e < 8; ++e) S[e] += f[e]; }
    bf16* yp = Y + (size_t)row0 * D + gi * 128 + c16 * 8;
#pragma unroll
    for (int i = 0; i < 8; ++i) {
        float own[8], gv[8]; unpack8(own, u[W - 1 + i]); unpack8(gv, g[i]);
#pragma unroll
        for (int e = 0; e < 8; ++e) S[e] += own[e];
        const int t = tf + i; const float inv = 1.0f / (float)((t + 1 < W) ? (t + 1) : W);
        float y[8];
#pragma unroll
        for (int e = 0; e < 8; ++e) y[e] = (S[e] * inv - own[e]) * ps[e] * silu_f(gv[e]);
        v4u o; o.x = pk2(y[0], y[1]); o.y = pk2(y[2], y[3]); o.z = pk2(y[4], y[5]); o.w = pk2(y[6], y[7]);
        *(v4u*)(yp + (size_t)i * D) = o;
        float old[8]; unpack8(old, u[i]);
#pragma unroll
        for (int e = 0; e < 8; ++e) S[e] -= old[e];
    }
}

__device__ __forceinline__ s16x4 vtr(LAS const unsigned char* p) { return __builtin_bit_cast(s16x4, __builtin_amdgcn_ds_read_tr16_b64_v4i16((LAS s16x4*)p)); }
template <bool DIAG> __device__ __forceinline__ void attn_tile(const bf16x8 (&qf)[4], bf16x8 (&kf)[4], v4u (&vv)[4], const bf16* kb, const bf16* vb, int kn, bool more,
                                                            LAS unsigned char* vw, const LAS unsigned char* vr, f32x16& o0, f32x16& o1, float& carry, int r32, int hi) {
    f32x16 p;
#pragma unroll
    for (int r = 0; r < 16; ++r) p[r] = 0.f;
#pragma unroll
    for (int d0 = 0; d0 < 4; ++d0) p = __builtin_amdgcn_mfma_f32_32x32x16_bf16(kf[d0], qf[d0], p, 0, 0, 0);
    LDS_WAIT();
#pragma unroll
    for (int i = 0; i < 4; ++i) *(LAS v4u*)(vw + 8 * i * 64) = vv[i];
    if (more) {
#pragma unroll
        for (int d0 = 0; d0 < 4; ++d0) kf[d0] = *(const bf16x8*)(kb + (size_t)kn * HD + 16 * d0);
#pragma unroll
        for (int i = 0; i < 4; ++i) vv[i] = *(const v4u*)(vb + (size_t)(kn + 8 * i) * HD); }
    float w[16], bt[16];
#pragma unroll
    for (int r = 0; r < 16; ++r) {
        const float e = __builtin_amdgcn_exp2f(__builtin_fminf(p[r], 126.0f));
        const float wi = __builtin_amdgcn_rcpf(1.0f + e);
        if (DIAG) { const bool valid = ((r & 3) + 8 * (r >> 2) + 4 * hi) < r32; w[r] = valid ? wi : 1.0f; bt[r] = valid ? e * wi : 0.f; }
        else { w[r] = wi; bt[r] = e * wi; }
    }
    float pr[4], up_[4];
#pragma unroll
    for (int m = 0; m < 4; ++m) { const float gsm = (w[4 * m] * w[4 * m + 1]) * (w[4 * m + 2] * w[4 * m + 3]);
        float ga = gsm, gb = gsm;
        asm volatile("s_nop 1\n\tv_permlane32_swap_b32 %0, %1\n\ts_nop 1" : "+v"(ga), "+v"(gb));
        pr[m] = ga * gb; up_[m] = gb; }
    float T[4]; T[3] = 1.0f; T[2] = pr[3]; T[1] = T[2] * pr[2]; T[0] = T[1] * pr[1];
    const float total = T[0] * pr[0];
    float a[16];
#pragma unroll
    for (int m = 0; m < 4; ++m) {
        const float base = (carry * T[m]) * (hi == 0 ? up_[m] : 1.0f);
        const float t3 = base, t2 = t3 * w[4 * m + 3], t1 = t2 * w[4 * m + 2], t0 = t1 * w[4 * m + 1];
        a[4 * m + 3] = bt[4 * m + 3] * t3; a[4 * m + 2] = bt[4 * m + 2] * t2; a[4 * m + 1] = bt[4 * m + 1] * t1; a[4 * m + 0] = bt[4 * m + 0] * t0;
    }
    carry *= total;
    v4u pw0, pw1;
    pw0.x = pk2(a[0], a[1]); pw0.y = pk2(a[2], a[3]); pw0.z = pk2(a[4], a[5]); pw0.w = pk2(a[6], a[7]);
    pw1.x = pk2(a[8], a[9]); pw1.y = pk2(a[10], a[11]); pw1.z = pk2(a[12], a[13]); pw1.w = pk2(a[14], a[15]);
    const bf16x8 pf0 = __builtin_bit_cast(bf16x8, pw0), pf1 = __builtin_bit_cast(bf16x8, pw1);
    LDS_WAIT();
    {
        const s16x4 a00 = vtr(vr + 0), a01 = vtr(vr + 512), a10 = vtr(vr + 1024), a11 = vtr(vr + 1536);
        const s16x4 b00 = vtr(vr + 2048), b01 = vtr(vr + 2048 + 512), b10 = vtr(vr + 2048 + 1024), b11 = vtr(vr + 2048 + 1536);
        const bf16x8 va0 = (bf16x8){a00[0], a00[1], a00[2], a00[3], a01[0], a01[1], a01[2], a01[3]};
        const bf16x8 va1 = (bf16x8){a10[0], a10[1], a10[2], a10[3], a11[0], a11[1], a11[2], a11[3]};
        const bf16x8 vb0 = (bf16x8){b00[0], b00[1], b00[2], b00[3], b01[0], b01[1], b01[2], b01[3]};
        const bf16x8 vb1 = (bf16x8){b10[0], b10[1], b10[2], b10[3], b11[0], b11[1], b11[2], b11[3]};
        o0 = __builtin_amdgcn_mfma_f32_32x32x16_bf16(va0, pf0, o0, 0, 0, 0);
        o0 = __builtin_amdgcn_mfma_f32_32x32x16_bf16(va1, pf1, o0, 0, 0, 0);
        o1 = __builtin_amdgcn_mfma_f32_32x32x16_bf16(vb0, pf0, o1, 0, 0, 0);
        o1 = __builtin_amdgcn_mfma_f32_32x32x16_bf16(vb1, pf1, o1, 0, 0, 0);
    }
    asm volatile("" ::: "memory");
}
__device__ __forceinline__ void swap_halves(unsigned& a, unsigned& b) { asm volatile("s_nop 1\n\tv_permlane32_swap_b32 %0, %1\n\ts_nop 1" : "+v"(a), "+v"(b)); }
__device__ __forceinline__ void load_gates(v4u (&g)[4], const bf16* p) {
#pragma unroll
    for (int j = 0; j < 4; ++j) g[j] = *(const v4u*)(p + 16 * j);
}
__device__ __forceinline__ void unswap_gates(v2u (&g)[8], const v4u (&L)[4]) {
#pragma unroll
    for (int j = 0; j < 4; ++j) { unsigned l0 = L[j].x, l1 = L[j].y, l2 = L[j].z, l3 = L[j].w; swap_halves(l0, l2); swap_halves(l1, l3); g[2 * j] = (v2u){l0, l1}; g[2 * j + 1] = (v2u){l2, l3}; }
}
__device__ __forceinline__ void attn_phase(const bf16* P, bf16* Y, LAS unsigned char* vl, int vgw, int ngw, int lane) {
    const int r32 = lane & 31, hi = lane >> 5;
    LAS unsigned char* vw = vl + ((lane & 7) >> 2) * 2048 + (lane >> 3) * 64 + (lane & 3) * 16;
    const LAS unsigned char* vr = vl + (4 * hi + ((lane & 15) >> 2)) * 64 + ((lane >> 4) & 1) * 32 + (lane & 3) * 8;
    constexpr int NITEM = BATCH * NH * (SEQ / 32);
    if (vgw >= NITEM) return;
    const size_t qoff = (size_t)r32 * HD + 8 * hi;
    bf16x8 qn[4]; v4u gn[4];
    { const int it = vgw, qt = it & 63; const size_t hb = (size_t)(it >> 6) * SEQ * HD + (size_t)qt * 32 * HD + qoff;
#pragma unroll
      for (int d0 = 0; d0 < 4; ++d0) qn[d0] = *(const bf16x8*)(P + B_Q + hb + 16 * d0);
      load_gates(gn, P + B_GS + hb); }
#pragma unroll 1
    for (int it = vgw; it < NITEM; it += ngw) {
        const int qt = it & 63, bh = it >> 6, b = bh >> 3, h = bh & 7, q0 = qt * 32;
        const size_t rowbase = (size_t)b * SEQ, hb = (size_t)bh * SEQ * HD;
        const bf16* kb = P + B_K + hb + qoff;
        const bf16* vb = P + B_V + hb + (size_t)lane * 8;
        bf16x8 qf[4], kf[4]; v4u vv[4]; v4u gr[4]; unsigned touch;
#pragma unroll
        for (int d0 = 0; d0 < 4; ++d0) { qf[d0] = qn[d0]; kf[d0] = *(const bf16x8*)(kb + (size_t)q0 * HD + 16 * d0); }
#pragma unroll
        for (int i = 0; i < 4; ++i) vv[i] = *(const v4u*)(vb + (size_t)(q0 + 8 * i) * HD);
#pragma unroll
        for (int e = 0; e < 4; ++e) gr[e] = gn[e];
        f32x16 o0, o1;
#pragma unroll
        for (int r = 0; r < 16; ++r) { o0[r] = 0.f; o1[r] = 0.f; }
        float carry = 1.0f;
        attn_tile<true>(qf, kf, vv, kb, vb, q0 - 32, qt > 0, vw, vr, o0, o1, carry, r32, hi);
        { const int itn = (it + ngw < NITEM) ? it + ngw : it;
          const size_t hbn = (size_t)(itn >> 6) * SEQ * HD + (size_t)(itn & 63) * 32 * HD + qoff;
#pragma unroll
          for (int d0 = 0; d0 < 4; ++d0) qn[d0] = *(const bf16x8*)(P + B_Q + hbn + 16 * d0);
          load_gates(gn, P + B_GS + hbn);
          touch = *(const unsigned*)(P + (hi ? B_V : B_K) + (size_t)(itn >> 6) * SEQ * HD + (size_t)((itn & 63) * 32 + r32) * HD); }
#pragma unroll 1
        for (int kt = qt - 1; kt >= 0; --kt) {
            if (__all(carry == 0.f)) break;
            attn_tile<false>(qf, kf, vv, kb, vb, (kt - 1) * 32, kt > 0, vw, vr, o0, o1, carry, r32, hi);
        }
        bf16* yp = Y + (rowbase + q0 + r32) * D + 512 + h * HD + 8 * hi;
        v2u yw[8], gv[8];
        unswap_gates(gv, gr);
#pragma unroll
        for (int dt = 0; dt < 2; ++dt)
#pragma unroll
            for (int m = 0; m < 4; ++m) {
                const v2u g = gv[4 * dt + m];
                const f32x16& o = dt ? o1 : o0;
                const float y0 = o[4 * m + 0] * silu_f(bflo(g.x)), y1 = o[4 * m + 1] * silu_f(bfhi(g.x));
                const float y2 = o[4 * m + 2] * silu_f(bflo(g.y)), y3 = o[4 * m + 3] * silu_f(bfhi(g.y));
                yw[4 * dt + m].x = pk2(y0, y1); yw[4 * dt + m].y = pk2(y2, y3); }
#pragma unroll
        for (int j = 0; j < 4; ++j) { unsigned a0 = yw[2 * j].x, a1 = yw[2 * j].y, b0 = yw[2 * j + 1].x, b1 = yw[2 * j + 1].y; swap_halves(a0, b0); swap_halves(a1, b1);
            *(v4u*)(yp + 16 * j) = (v4u){a0, a1, b0, b1}; }
        asm volatile("" :: "v"(touch));
    }
}

__device__ __forceinline__ void p5_rows(const float* x, const float* g_post, const float* mod, const bf16* Yo, const float* ssq, float* out, int gw, int ngw, int lane) {
    constexpr int RPW = 32, PF = 4;
    for (int it = gw; it < M / RPW; it += ngw) {
        const int row0 = it * RPW, b = row0 / SEQ;
        f32x4 gg[4];
#pragma unroll
        for (int j = 0; j < 2; ++j)
#pragma unroll
            for (int e = 0; e < 2; ++e) { const int k = 8 * lane + 512 * j + 4 * e; gg[2 * j + e] = *(const f32x4*)(g_post + k) * *(const f32x4*)(mod + (size_t)b * NIN + 2048 + k); }
        float rstd_l;
        { const f32x4* sq = (const f32x4*)(ssq + (size_t)(row0 + (lane & 31)) * 16);
          const f32x4 s0 = sq[0], s1 = sq[1], s2 = sq[2], s3 = sq[3];
          const float ss = ((s0[0] + s0[1]) + (s0[2] + s0[3])) + ((s1[0] + s1[1]) + (s1[2] + s1[3])) + ((s2[0] + s2[1]) + (s2[2] + s2[3])) + ((s3[0] + s3[1]) + (s3[2] + s3[3]));
          rstd_l = 1.0f / sqrtf(ss * (1.0f / D) + EPS); }
        const float* xb = x + (size_t)row0 * D + 8 * lane;
        const bf16* yb = Yo + (size_t)row0 * D + 8 * lane;
        float* ob = out + (size_t)row0 * D + 8 * lane;
        v4u ybuf[PF][2]; f32x4 xbuf[PF][4];
#pragma unroll
        for (int p = 0; p < PF; ++p)
#pragma unroll
            for (int j = 0; j < 2; ++j) { ybuf[p][j] = __builtin_nontemporal_load((const v4u*)(yb + (size_t)p * D + 512 * j));
                xbuf[p][2 * j] = __builtin_nontemporal_load((const f32x4*)(xb + (size_t)p * D + 512 * j)); xbuf[p][2 * j + 1] = __builtin_nontemporal_load((const f32x4*)(xb + (size_t)p * D + 512 * j + 4)); }
#pragma unroll 1
        for (int r = 0; r < RPW; r += PF) {
#pragma unroll
            for (int p = 0; p < PF; ++p) {
                v4u y[2]; f32x4 xv[4];
#pragma unroll
                for (int j = 0; j < 2; ++j) { y[j] = ybuf[p][j]; xv[2 * j] = xbuf[p][2 * j]; xv[2 * j + 1] = xbuf[p][2 * j + 1]; }
                { const size_t ro = (size_t)((r + p + PF < RPW) ? (r + p + PF) : (RPW - 1)) * D;
#pragma unroll
                    for (int j = 0; j < 2; ++j) { ybuf[p][j] = __builtin_nontemporal_load((const v4u*)(yb + ro + 512 * j));
                        xbuf[p][2 * j] = __builtin_nontemporal_load((const f32x4*)(xb + ro + 512 * j)); xbuf[p][2 * j + 1] = __builtin_nontemporal_load((const f32x4*)(xb + ro + 512 * j + 4)); } }
                const float rstd = __builtin_bit_cast(float, __builtin_amdgcn_readlane(__builtin_bit_cast(int, rstd_l), r + p));
                float* op = ob + (size_t)(r + p) * D;
#pragma unroll
                for (int j = 0; j < 2; ++j) {
                    const f32x4 y0 = {bflo(y[j].x), bfhi(y[j].x), bflo(y[j].y), bfhi(y[j].y)}, y1 = {bflo(y[j].z), bfhi(y[j].z), bflo(y[j].w), bfhi(y[j].w)};
                    __builtin_nontemporal_store(xv[2 * j] + gg[2 * j] * (y0 * rstd), (f32x4*)(op + 512 * j));
                    __builtin_nontemporal_store(xv[2 * j + 1] + gg[2 * j + 1] * (y1 * rstd), (f32x4*)(op + 512 * j + 4)); }
            }
        }
    }
}

__global__ void __launch_bounds__(NTHREADS, 2) fwd_kernel(Args args) {
    extern __shared__ __attribute__((aligned(16))) unsigned char lds_raw[];
    LAS unsigned char* lds = (LAS unsigned char*)lds_raw;
    const int tid = threadIdx.x, lane = tid & 63, wave = __builtin_amdgcn_readfirstlane(tid >> 6);
    const int G = gridDim.x, gw = blockIdx.x * NWAVES + wave, ngw = G * NWAVES;
    unsigned char* ws = args.ws;
    const float* x = args.in[0]; const float* c = args.in[1]; const float* w_ada = args.in[2]; const float* b_ada = args.in[3]; const float* g_pre = args.in[4];
    const float* w_in = args.in[5]; const float* w_pool = args.in[6]; const float* pool_scale = args.in[7]; const float* w_out = args.in[8]; const float* g_post = args.in[9];
    float* mod = (float*)(ws + WS_MOD); bf16* Win_t = (bf16*)(ws + WS_WIN); bf16* Wout_t = (bf16*)(ws + WS_WOUT);
    float* ssq = (float*)(ws + WS_SSQ); bf16* H = (bf16*)(ws + WS_H); bf16* Y = (bf16*)(ws + WS_H); bf16* P = (bf16*)(ws + WS_P); bf16* Yo = (bf16*)(ws + WS_YO);
    const int lo = args.ph_lo, hi_ = args.ph_hi;
    if (tid < 2) ((volatile LAS unsigned*)(lds + LDS_BARST))[tid] = 0u;
    __syncthreads();
    XcdBarrier xbar; xbar.bar = (unsigned*)(ws + WS_BAR); xbar.x = 0; xbar.st = (volatile LAS unsigned*)(lds + LDS_BARST);
#define IN(k) (lo <= (k) && (k) < hi_)
#define SEAM(k) do { if (IN(k) && IN((k) + 1)) { if ((k) == 0) { cg::this_grid().sync(); xbar = xcd_barrier_post((unsigned*)(ws + WS_BAR), (volatile LAS unsigned*)(lds + LDS_BARST)); } else xcd_barrier(xbar); } } while (0)

    if (IN(0)) {
        if (blockIdx.x == 0) for (int i = tid; i < XCD_BAR_WORDS; i += NTHREADS) ((unsigned*)(ws + WS_BAR))[i] = 0u;
        for (int it = blockIdx.x; it < 192; it += G) p0_adaln_item(c, w_ada, b_ada, mod, lds, it, tid);
    }
    SEAM(0);
    if (IN(1)) p1_rows(x, g_pre, mod, H, gw, ngw, lane);
    if (IN(1)) {
        for (int it = blockIdx.x; it < 4 * (D / 16); it += G) p0_fold_item(w_in, w_pool, Win_t, lds, it, tid);
        LAS float* scr = (LAS float*)(lds + wave * 16384);
        constexpr int NB_IN = (NIN - 512) / 32, I_IN = (D / 64) * NB_IN, I_OUT = (D / 64) * (D / 32);
        for (int it = gw; it < I_IN + I_OUT; it += ngw) {
            int r = it;
            if (r < I_IN) { const int kb = r / NB_IN, nb = 16 + r % NB_IN; p0_transpose_item(w_in, D, NIN, Win_t, scr, kb * (NIN / 32) + nb, lane); continue; } r -= I_IN;
            p0_transpose_item(w_out, D, D, Wout_t, scr, r, lane);
        }
    }
    SEAM(1);
    if (IN(2)) {
        pg8::Gemm g{H, Win_t, M, NIN, D}; pg8::StaticOrder S; S.init(M, NIN, G, (int)blockIdx.x, WGM_IN);
        pg8::EpiP E{P};
        pg8::gemm_phase<pg8::EpiP, pg8::StaticOrder, true, true>(lds, g, S, E);
    }
    SEAM(2);
    if (IN(3)) {
        LAS unsigned char* vl = lds + wave * 16384;
#define POOL_ALL() for (int it = gw; it < (M / 32) * 4; it += ngw) { const int tt = it & (M / 32 - 1), gi = (tt + (it >> 11)) & 3; \
                    if (gi == 0) pool_item<2>(P, pool_scale, Y, tt, 0, lane); else if (gi == 1) pool_item<4>(P, pool_scale, Y, tt, 1, lane); \
                    else if (gi == 2) pool_item<8>(P, pool_scale, Y, tt, 2, lane); else pool_item<16>(P, pool_scale, Y, tt, 3, lane); }
        const int vgw = ((G % 8 == 0) ? ((int)blockIdx.x % 8) * (G / 8) + (int)blockIdx.x / 8 : (int)blockIdx.x) * NWAVES + wave;
        if (wave < 4) { attn_phase(P, Y, vl, vgw, ngw, lane); POOL_ALL(); }
        else { POOL_ALL(); attn_phase(P, Y, vl, vgw, ngw, lane); }
#undef POOL_ALL
    }
    SEAM(3);
    if (IN(4)) {
        pg8::Gemm g{Y, Wout_t, M, D, D}; pg8::StaticOrder S; S.init(M, D, G, (int)blockIdx.x, WGM_OUT);
        pg8::EpiY E{Yo, D, ssq};
        pg8::gemm_phase<pg8::EpiY, pg8::StaticOrder, true, true>(lds, g, S, E);
    }
    SEAM(4);
    if (IN(5)) p5_rows(x, g_post, mod, Yo, ssq, args.out, gw, ngw, lane);

#undef IN
#undef SEAM
}

#ifndef MK_N_LAUNCHES
#define MK_N_LAUNCHES 1
#endif
extern "C" void kernel_launch(void* const* d_in, const int* in_sizes, int n_in, void* d_out, int out_size, void* d_ws, size_t ws_size, hipStream_t stream) {
    static int grid = 0;
    if (grid == 0) {
        if (n_in != 10 || in_sizes[0] != M * D || out_size != M * D || ws_size < WS_END) { fprintf(stderr, "kernel_launch: unexpected shapes (n_in %d, in0 %d, out %d, ws %zu); nothing launched\n", n_in, n_in > 0 ? in_sizes[0] : -1, out_size, ws_size); grid = -1; return; }
        int dev = 0, cus = 0, per_cu = 0;
        if (hipGetDevice(&dev) != hipSuccess || hipDeviceGetAttribute(&cus, hipDeviceAttributeMultiprocessorCount, dev) != hipSuccess) { grid = -1; return; }
        if (hipFuncSetAttribute((const void*)fwd_kernel, hipFuncAttributeMaxDynamicSharedMemorySize, LDS_BYTES) != hipSuccess) { fprintf(stderr, "kernel_launch: hipFuncSetAttribute failed\n"); grid = -1; return; }
        if (hipOccupancyMaxActiveBlocksPerMultiprocessor(&per_cu, (const void*)fwd_kernel, NTHREADS, LDS_BYTES) != hipSuccess || per_cu < 1) { fprintf(stderr, "kernel_launch: occupancy query says %d blocks per CU\n", per_cu); per_cu = 1; }
        (void)hipGetLastError();
        grid = cus * 1;
    }
    if (grid < 0) return;
    Args a{};
    for (int i = 0; i < 10; ++i) a.in[i] = (const float*)d_in[i];
    a.out = (float*)d_out; a.ws = (unsigned char*)d_ws;
#if MK_N_LAUNCHES == 1
    a.ph_lo = 0; a.ph_hi = 6;
    void* kargs[] = {&a};
    hipError_t e = hipLaunchCooperativeKernel((const void*)fwd_kernel, dim3(grid), dim3(NTHREADS), kargs, LDS_BYTES, stream);
    if (e != hipSuccess) fprintf(stderr, "kernel_launch: cooperative launch failed: %s (grid %d)\n", hipGetErrorString(e), grid);
#else
    for (int ph = 0; ph < 6; ++ph) { a.ph_lo = ph; a.ph_hi = ph + 1; hipLaunchKernelGGL(fwd_kernel, dim3(grid), dim3(NTHREADS), LDS_BYTES, stream, a); }
#endif
}
```

```cpp
#include <hip/hip_runtime.h>
#include <hip/hip_cooperative_groups.h>
#include <cstdio>
#include <cstdint>
namespace cg = cooperative_groups;
namespace pg8 {
#define PG8_LAS __attribute__((address_space(3)))
typedef unsigned short bf16_t;
typedef short bf16x8 __attribute__((ext_vector_type(8)));
typedef float f32x4 __attribute__((ext_vector_type(4)));
typedef unsigned u32x4 __attribute__((ext_vector_type(4)));
constexpr int BM = 256, BK = 64, HALF = 128, HTB = HALF * BK * 2  , STAGE_BYTES = 8 * HTB, NXCD = 8, WGM = 8;

__host__ __device__ __forceinline__ int lds_byte(int r, int c) { const int st = (r >> 4) * 2 + (c >> 5), rr = r & 15, cc = c & 31, ob = rr * 64 + cc * 2; return st * 1024 + (ob ^ (((ob >> 9) & 1) << 5)); }
__host__ __device__ __forceinline__ void stage_rc(int b, int& R, int& C) { const int st = b / 1024, sb = b % 1024, swz = sb ^ (((sb >> 9) & 1) << 5); R = (st >> 1) * 16 + swz / 64; C = (st & 1) * 32 + (swz % 64) / 2; }
__host__ __device__ __forceinline__ int perm32(int rho) { const int n = rho >> 4, i = rho & 15; return 8 * (i >> 2) + 4 * n + (i & 3); }

struct Unit { int pm, pn; };
struct Gemm { const bf16_t* A; const bf16_t* Bt; int M, N, K; };

struct StaticOrder {
    int nM, nN, nwg, G, c, wgm;
    __host__ __device__ void init(int M, int N, int G_, int c_, int wgm_ = WGM) { nM = M / BM; nN = N / BM; nwg = nM * nN; G = G_; c = c_; wgm = wgm_; }
    __host__ __device__ bool next(int i, Unit& u) const {
        const long L = (long)i * G + c; if (L >= nwg) return false;
        int wgid = (int)L; { const int q = nwg / NXCD, r = nwg % NXCD, xcd = wgid % NXCD, off = wgid / NXCD; wgid = (xcd < r ? xcd * (q + 1) : r * (q + 1) + (xcd - r) * q) + off; }
        const int nig = wgm * nN, gid = wgid / nig, fm = gid * wgm, gsz = (nM - fm) < wgm ? (nM - fm) : wgm;
        u.pm = fm + ((wgid % nig) % gsz); u.pn = (wgid % nig) / gsz; return true;
    }
    __device__ __forceinline__ void a_ready(const Unit&) const {}
    __device__ __forceinline__ void done(const Unit&) const {}
};

__device__ __forceinline__ unsigned cvt_pk_bf16(float lo, float hi) { unsigned r; asm volatile("v_cvt_pk_bf16_f32 %0, %1, %2" : "=v"(r) : "v"(lo), "v"(hi)); return r; }
typedef unsigned u32x2 __attribute__((ext_vector_type(2)));
constexpr float QSCALE = 0.125f * 1.4426950408889634f;
struct EpiP {
    static constexpr bool PERM = true, AFTER_DRAIN = false;
    bf16_t* O;
    __device__ __forceinline__ void operator()(const f32x4 (&acc)[2][2][4][2], const Unit& u, int wr, int wc, int fr, int fq) const {
        const int blk = u.pn >> 1, b = u.pm >> 3, t0 = (u.pm & 7) * BM + wr * 64 + fr;
        const float sc = (blk == 2) ? QSCALE : 1.f;
        bf16_t* blkp = O + (size_t)blk * (65536u * 512u);
#pragma unroll
        for (int bj = 0; bj < 2; ++bj) {
            const int c512 = (u.pn & 1) * BM + bj * HALF + wc * 32 + 8 * fq;
            bf16_t* cp = (blk < 2) ? blkp + ((size_t)(b * 4 + (c512 >> 7)) * 2048) * 128 + (c512 & 127) : blkp + ((size_t)(b * 8 + (c512 >> 6)) * 2048) * 64 + (c512 & 63);
            const int rs = (blk < 2) ? 128 : 64;
#pragma unroll
            for (int ai = 0; ai < 2; ++ai)
#pragma unroll
                for (int m = 0; m < 4; ++m) { const f32x4 v0 = acc[ai][bj][m][0] * sc, v1 = acc[ai][bj][m][1] * sc;
                    u32x4 w; w.x = cvt_pk_bf16(v0[0], v0[1]); w.y = cvt_pk_bf16(v0[2], v0[3]); w.z = cvt_pk_bf16(v1[0], v1[1]); w.w = cvt_pk_bf16(v1[2], v1[3]);
                    *(u32x4*)(cp + (size_t)(t0 + ai * HALF + m * 16) * rs) = w; }
        }
    }
};
struct EpiY {
    static constexpr bool PERM = true, AFTER_DRAIN = false;
    bf16_t* O; int ldc; float* ssq;
    __device__ __forceinline__ void operator()(const f32x4 (&acc)[2][2][4][2], const Unit& u, int wr, int wc, int fr, int fq) const {
        const int row0 = u.pm * BM + wr * 64 + fr, col0 = u.pn * BM + wc * 32 + 8 * fq;
#pragma unroll
        for (int ai = 0; ai < 2; ++ai)
#pragma unroll
            for (int m = 0; m < 4; ++m) { const int row = row0 + ai * HALF + m * 16; bf16_t* rowp = O + (size_t)row * ldc + col0; float s = 0.f;
#pragma unroll
                for (int bj = 0; bj < 2; ++bj) { const f32x4 v0 = acc[ai][bj][m][0], v1 = acc[ai][bj][m][1];
                    s += (v0[0] * v0[0] + v0[1] * v0[1]) + (v0[2] * v0[2] + v0[3] * v0[3]) + (v1[0] * v1[0] + v1[1] * v1[1]) + (v1[2] * v1[2] + v1[3] * v1[3]);
                    u32x4 w; w.x = cvt_pk_bf16(v0[0], v0[1]); w.y = cvt_pk_bf16(v0[2], v0[3]); w.z = cvt_pk_bf16(v1[0], v1[1]); w.w = cvt_pk_bf16(v1[2], v1[3]);
                    *(u32x4*)(rowp + bj * HALF) = w; }
                s += __shfl_xor(s, 16); s += __shfl_xor(s, 32);
                if (fq == 0) ssq[(size_t)row * 16 + u.pn * 4 + wc] = s; }
    }
};
template <class Epi, class Sched, bool ALIGN_EPI = false, bool SP2 = false>
__device__ __forceinline__ void gemm_phase(PG8_LAS unsigned char* lds, const Gemm g, const Sched& S, const Epi& E) {
    const int tid = threadIdx.x, wid = __builtin_amdgcn_readfirstlane(tid >> 6), lane = tid & 63, wr = wid >> 2, wc = wid & 3, fr = lane & 15, fq = lane >> 4;
    const int K = g.K, nt = K / BK;
    unsigned voffA[2], voffB[2];
#pragma unroll
    for (int i = 0; i < 2; ++i) { int R, C; stage_rc(tid * 16 + i * 8192, R, C); const int Rb = Epi::PERM ? ((R & ~31) + perm32(R & 31)) : R;
        voffA[i] = (unsigned)(R * K + C) * 2u; voffB[i] = (unsigned)(Rb * K + C) * 2u; }
    const size_t kstep = (size_t)(BK * 2);
    const size_t hstep = (size_t)HALF * K * 2;
    const size_t tstep = 2 * hstep;
    const unsigned ldsw = (unsigned)wid * 1024u;
    const int aoff = lds_byte(wr * 64 + fr, fq * 8), boff = lds_byte(wc * 32 + fr, fq * 8);
#define PG8_SA(b, h) (((b) * 2 + (h)) * HTB)
#define PG8_SB(b, h) ((4 + (b) * 2 + (h)) * HTB)
#define PG8_STAGE(bufoff, gbase, voff) do { _Pragma("unroll") for (int _i = 0; _i < 2; ++_i) \
        __builtin_amdgcn_global_load_lds((const unsigned*)((const char*)(gbase) + (voff)[_i]), (PG8_LAS unsigned*)(lds + (bufoff) + ldsw + _i * 8192), 16, 0, 0); } while (0)
#define PG8_LDA(dst, b, h) do { _Pragma("unroll") for (int m = 0; m < 4; ++m) _Pragma("unroll") for (int k = 0; k < 2; ++k) dst[m][k] = *(const PG8_LAS bf16x8*)(lds + PG8_SA(b, h) + aoff + m * 2048 + k * 1024); } while (0)
#define PG8_LDB(dst, b, h) do { _Pragma("unroll") for (int n = 0; n < 2; ++n) _Pragma("unroll") for (int k = 0; k < 2; ++k) dst[n][k] = *(const PG8_LAS bf16x8*)(lds + PG8_SB(b, h) + boff + n * 2048 + k * 1024); } while (0)
#define PG8_MMA(ai, bj, At, Bt) do { __builtin_amdgcn_s_setprio(1); _Pragma("unroll") for (int m = 0; m < 4; ++m) _Pragma("unroll") for (int n = 0; n < 2; ++n) _Pragma("unroll") for (int k = 0; k < 2; ++k) \
        acc[ai][bj][m][n] = __builtin_amdgcn_mfma_f32_16x16x32_bf16(Bt[n][k], At[m][k], acc[ai][bj][m][n], 0, 0, 0); __builtin_amdgcn_s_setprio(0); } while (0)
#define PG8_WAIT_V(n) asm volatile("s_waitcnt vmcnt(" #n ")" ::: "memory")
#define PG8_WAIT_L(n) asm volatile("s_waitcnt lgkmcnt(" #n ")" ::: "memory")
#define PG8_BAR __builtin_amdgcn_s_barrier()
#define PG8_SCHED __builtin_amdgcn_sched_barrier(0)
    Unit cur, nxt; int ui = 0;
    if (!S.next(0, cur)) return;
    f32x4 acc[2][2][4][2];
#pragma unroll
    for (int a = 0; a < 2; ++a)
#pragma unroll
        for (int b = 0; b < 2; ++b)
#pragma unroll
            for (int m = 0; m < 4; ++m)
#pragma unroll
                for (int n = 0; n < 2; ++n) acc[a][b][m][n] = (f32x4){0.f, 0.f, 0.f, 0.f};
    bf16x8 At[4][2], B0[2][2], B1[2][2];
    const char* cA = (const char*)g.A + (size_t)cur.pm * tstep; const char* cB = (const char*)g.Bt + (size_t)cur.pn * tstep;
    S.a_ready(cur);
    if constexpr (SP2) {
        PG8_STAGE(PG8_SB(0, 0), cB, voffB); PG8_STAGE(PG8_SB(0, 1), cB + hstep, voffB); PG8_STAGE(PG8_SA(0, 0), cA, voffA); PG8_STAGE(PG8_SA(0, 1), cA + hstep, voffA);
        if (wr == 1) PG8_BAR;
        PG8_WAIT_V(2); PG8_BAR;
        PG8_STAGE(PG8_SB(1, 0), cB + kstep, voffB); PG8_STAGE(PG8_SA(1, 0), cA + kstep, voffA); PG8_STAGE(PG8_SB(1, 1), cB + hstep + kstep, voffB);
        PG8_WAIT_V(6); PG8_BAR;
    } else {
        PG8_STAGE(PG8_SB(0, 0), cB, voffB); PG8_STAGE(PG8_SA(0, 0), cA, voffA); PG8_STAGE(PG8_SB(0, 1), cB + hstep, voffB); PG8_STAGE(PG8_SA(0, 1), cA + hstep, voffA);
        if (wr == 1) PG8_BAR;
        PG8_WAIT_V(4); PG8_BAR;
        PG8_STAGE(PG8_SB(1, 0), cB + kstep, voffB); PG8_STAGE(PG8_SA(1, 0), cA + kstep, voffA); PG8_STAGE(PG8_SB(1, 1), cB + hstep + kstep, voffB);
        PG8_WAIT_V(6); PG8_BAR;
    }
    for (;;) {
        const bool has_next = S.next(ui + 1, nxt);
        const char* nA = has_next ? (const char*)g.A + (size_t)nxt.pm * tstep : cA; const char* nB = has_next ? (const char*)g.Bt + (size_t)nxt.pn * tstep : cB;
        for (int t = 0; t < nt; t += 2) {
            const bool last = (t == nt - 2);
            const char* a1 = cA + (size_t)(t + 1) * kstep;
            const char* a2 = last ? nA : cA + (size_t)(t + 2) * kstep; const char* b2 = last ? nB : cB + (size_t)(t + 2) * kstep;
            const char* a3 = a2 + kstep; const char* b3 = b2 + kstep;
            if (last && has_next) S.a_ready(nxt);
            if constexpr (SP2) {
            PG8_LDB(B0, 0, 0); PG8_LDB(B1, 0, 1); PG8_SCHED; PG8_LDA(At, 0, 0); PG8_STAGE(PG8_SA(1, 1), a1 + hstep, voffA);
            PG8_WAIT_V(8); PG8_WAIT_L(0); PG8_BAR; PG8_MMA(0, 0, At, B0); PG8_MMA(0, 1, At, B1); PG8_BAR; PG8_SCHED;
            PG8_LDA(At, 0, 1); PG8_STAGE(PG8_SB(0, 0), b2, voffB); PG8_STAGE(PG8_SB(0, 1), b2 + hstep, voffB); PG8_STAGE(PG8_SA(0, 0), a2, voffA);
            PG8_WAIT_V(8); PG8_WAIT_L(0); PG8_BAR; PG8_MMA(1, 0, At, B0); PG8_MMA(1, 1, At, B1); PG8_BAR; PG8_SCHED;
            PG8_LDB(B0, 1, 0); PG8_LDB(B1, 1, 1); PG8_SCHED; PG8_LDA(At, 1, 0); PG8_STAGE(PG8_SA(0, 1), a2 + hstep, voffA);
            PG8_WAIT_V(8); PG8_WAIT_L(0); PG8_BAR; PG8_MMA(0, 0, At, B0); PG8_MMA(0, 1, At, B1); PG8_BAR; PG8_SCHED;
            PG8_LDA(At, 1, 1); PG8_STAGE(PG8_SB(1, 0), b3, voffB); PG8_STAGE(PG8_SB(1, 1), b3 + hstep, voffB); PG8_STAGE(PG8_SA(1, 0), a3, voffA);
            PG8_WAIT_V(8); PG8_WAIT_L(0); PG8_BAR; PG8_MMA(1, 0, At, B0); PG8_MMA(1, 1, At, B1); PG8_BAR; PG8_SCHED;
            } else {
            PG8_LDB(B0, 0, 0); PG8_SCHED; PG8_LDA(At, 0, 0); PG8_STAGE(PG8_SA(1, 1), a1 + hstep, voffA);
            PG8_WAIT_L(8); PG8_BAR; PG8_WAIT_L(0); PG8_MMA(0, 0, At, B0); PG8_BAR; PG8_SCHED;
            PG8_LDB(B1, 0, 1); PG8_STAGE(PG8_SB(0, 0), b2, voffB);
            PG8_BAR; PG8_WAIT_L(0); PG8_MMA(0, 1, At, B1); PG8_BAR;
            PG8_LDA(At, 0, 1); PG8_STAGE(PG8_SA(0, 0), a2, voffA);
            PG8_BAR; PG8_WAIT_L(0); PG8_MMA(1, 0, At, B0); PG8_BAR; PG8_SCHED;
            PG8_STAGE(PG8_SB(0, 1), b2 + hstep, voffB);
            PG8_WAIT_V(6); PG8_BAR; PG8_MMA(1, 1, At, B1); PG8_BAR;
            PG8_LDB(B0, 1, 0); PG8_SCHED; PG8_LDA(At, 1, 0); PG8_STAGE(PG8_SA(0, 1), a2 + hstep, voffA);
            PG8_WAIT_L(8); PG8_BAR; PG8_WAIT_L(0); PG8_MMA(0, 0, At, B0); PG8_BAR; PG8_SCHED;
            PG8_LDB(B1, 1, 1); PG8_STAGE(PG8_SB(1, 0), b3, voffB);
            PG8_BAR; PG8_WAIT_L(0); PG8_MMA(0, 1, At, B1); PG8_BAR;
            PG8_LDA(At, 1, 1); PG8_STAGE(PG8_SA(1, 0), a3, voffA);
            PG8_BAR; PG8_WAIT_L(0); PG8_MMA(1, 0, At, B0); PG8_BAR; PG8_SCHED;
            PG8_STAGE(PG8_SB(1, 1), b3 + hstep, voffB);
            PG8_WAIT_V(6); PG8_BAR; PG8_MMA(1, 1, At, B1); PG8_BAR;
            }
        }
        if constexpr (ALIGN_EPI) { if (wr == 0) PG8_BAR; }
        if constexpr (!Epi::AFTER_DRAIN) { E(acc, cur, wr, wc, fr, fq); S.done(cur); }
        if (!has_next) break;
#pragma unroll
        for (int a = 0; a < 2; ++a)
#pragma unroll
            for (int b = 0; b < 2; ++b)
#pragma unroll
                for (int m = 0; m < 4; ++m)
#pragma unroll
                    for (int n = 0; n < 2; ++n) acc[a][b][m][n] = (f32x4){0.f, 0.f, 0.f, 0.f};
        cur = nxt; cA = nA; cB = nB; ++ui;
        if constexpr (ALIGN_EPI) { if (wr == 1) PG8_BAR; }
    }
    PG8_WAIT_V(0);
    if constexpr (!ALIGN_EPI) { if (wr == 0) PG8_BAR; }
    PG8_BAR;
    if constexpr (Epi::AFTER_DRAIN) { E.fused(acc, cur, wr, wc, fr, fq, lds, wid, lane); S.done(cur); }
#undef PG8_SA
#undef PG8_SB
#undef PG8_STAGE
#undef PG8_LDA
#undef PG8_LDB
#undef PG8_MMA
#undef PG8_WAIT_V
#undef PG8_WAIT_L
#undef PG8_BAR
#undef PG8_SCHED
}
}
constexpr int BATCH = 32, SEQ = 2048, D = 1024, M = BATCH * SEQ, NIN = 3072, NH = 8, HD = 64;
constexpr size_t PBLK = (size_t)65536 * 512;
constexpr size_t B_U = 0, B_GP = PBLK, B_Q = 2 * PBLK, B_K = 3 * PBLK, B_V = 4 * PBLK, B_GS = 5 * PBLK;
constexpr float EPS = 1e-6f, LOG2E = 1.4426950408889634f;
constexpr int NWAVES = 8, NTHREADS = NWAVES * 64;
#ifndef WGM_IN
#define WGM_IN 24
#endif
#ifndef WGM_OUT
#define WGM_OUT 16
#endif
constexpr int WGM_IN_ = WGM_IN, WGM_OUT_ = WGM_OUT;
constexpr size_t MiB = 1u << 20;
constexpr size_t WS_MOD = 0;
constexpr size_t WS_WIN = 1 * MiB;
constexpr size_t WS_WOUT = 8 * MiB;
constexpr size_t WS_SSQ = 12 * MiB;
constexpr size_t WS_H = 16 * MiB;
constexpr size_t WS_P = 144 * MiB;
constexpr size_t WS_YO = 528 * MiB;
constexpr size_t WS_END = 656 * MiB;
constexpr size_t WS_BAR = 11 * MiB;
constexpr int RING_BYTES = 131072, LDS_BYTES = 147456, LDS_BARST = RING_BYTES + 8192;

#define GAS __attribute__((address_space(1)))
#define LAS __attribute__((address_space(3)))
typedef unsigned short bf16;
typedef unsigned v4u __attribute__((ext_vector_type(4)));
typedef unsigned v2u __attribute__((ext_vector_type(2)));
typedef float f32x4 __attribute__((ext_vector_type(4)));
typedef float f32x16 __attribute__((ext_vector_type(16)));
typedef short bf16x8 __attribute__((ext_vector_type(8)));
typedef short s16x4 __attribute__((ext_vector_type(4)));
#define LDS_WAIT() asm volatile("s_waitcnt lgkmcnt(0)" ::: "memory")
__device__ __forceinline__ unsigned f2bf(float f) { unsigned u = __builtin_bit_cast(unsigned, f); return (u + 0x7fffu + ((u >> 16) & 1u)) >> 16; }
__device__ __forceinline__ unsigned pk2(float lo, float hi) { return pg8::cvt_pk_bf16(lo, hi); }
__device__ __forceinline__ float bflo(unsigned w) { return __builtin_bit_cast(float, w << 16); }
__device__ __forceinline__ float bfhi(unsigned w) { return __builtin_bit_cast(float, w & 0xffff0000u); }
__device__ __forceinline__ float silu_f(float g) { return g * __builtin_amdgcn_rcpf(1.0f + __builtin_amdgcn_exp2f(-g * LOG2E)); }
__device__ __forceinline__ float wave_sum(float v) {
#pragma unroll
    for (int o = 1; o < 64; o <<= 1) v += __shfl_xor(v, o);
    return v;
}

#define XB_TMO      128
#define XB_XCNT(j)  (256  + 64 * (j))
#define XB_XSUB(j)  (1280 + 64 * (j))
#define XB_XGEN(j)  (2304 + 64 * (j))
#define XB_TOP      3328
#define XB_TOPGEN   3392
#define XCD_BAR_WORDS 3456
#define XB_SPIN_CAP (1u << 18)

__device__ __forceinline__ unsigned xb_ld(unsigned* p)              { return __hip_atomic_load(p, __ATOMIC_RELAXED, __HIP_MEMORY_SCOPE_AGENT); }
__device__ __forceinline__ unsigned xb_add(unsigned* p, unsigned v) { return __hip_atomic_fetch_add(p, v, __ATOMIC_RELAXED, __HIP_MEMORY_SCOPE_AGENT); }
__device__ __forceinline__ unsigned xb_xcc_id() { return (unsigned)__builtin_amdgcn_s_getreg((3 << 11) | 20) & 0xFu; }
#define XB_SPIN(cond, bar) do { unsigned _sp = 0; while (cond) { __builtin_amdgcn_s_sleep(1); \
    if ((++_sp & 255u) == 0u) { if (xb_ld(&(bar)[XB_TMO])) break; if (_sp > XB_SPIN_CAP) { atomicAdd(&(bar)[XB_TMO], 1u); break; } } } } while (0)

struct XcdBarrier {
    unsigned* bar; unsigned x;
    volatile LAS unsigned* st;
};

__device__ __forceinline__ XcdBarrier xcd_barrier_post(unsigned* bar, volatile LAS unsigned* st) {
    XcdBarrier b; b.bar = bar; b.x = xb_xcc_id(); b.st = st;
    if (threadIdx.x == 0) (void)xb_add(&bar[XB_XCNT(b.x)], 1u);
    return b;
}
__device__ __forceinline__ void xcd_barrier_complete(unsigned* bar, unsigned x, unsigned& nloc, unsigned& nx) {
    const unsigned G = gridDim.x * gridDim.y * gridDim.z;
    unsigned sum, cnt, mine, sp = 0u;
    for (;;) {
        sum = 0u; cnt = 0u; mine = 0u;
#pragma unroll
        for (unsigned j = 0; j < 16; ++j) { const unsigned c = xb_ld(&bar[XB_XCNT(j)]); sum += c; cnt += (c > 0u) ? 1u : 0u; mine = (j == x) ? c : mine; }
        if (sum == G) break;
        __builtin_amdgcn_s_sleep(1);
        if ((++sp & 255u) == 0u) { if (xb_ld(&bar[XB_TMO])) break; if (sp > XB_SPIN_CAP) { atomicAdd(&bar[XB_TMO], 1u); break; } }
    }
    nloc = mine > 0u ? mine : 1u; nx = cnt > 0u ? cnt : 1u;
}

__device__ __forceinline__ void xcd_barrier(const XcdBarrier& b) {
    asm volatile("s_waitcnt vmcnt(0)" ::: "memory");
    __syncthreads();
    if (threadIdx.x == 0) {
        unsigned* bar = b.bar;
        __builtin_amdgcn_s_waitcnt(0);
        unsigned nloc = b.st[0], nx = b.st[1];
        if (nloc == 0u) { xcd_barrier_complete(bar, b.x, nloc, nx); b.st[0] = nloc; b.st[1] = nx; }
        const unsigned old = xb_add(&bar[XB_XSUB(b.x)], 1u);
        const unsigned gen = old / nloc;
        if (old + 1u == (gen + 1u) * nloc) {
            __builtin_amdgcn_fence(__ATOMIC_RELEASE, "agent");
            asm volatile("s_waitcnt vmcnt(0)" ::: "memory");
            const unsigned og = xb_add(&bar[XB_TOP], 1u);
            const unsigned tg = og / nx;
            if (og + 1u == (tg + 1u) * nx) xb_add(&bar[XB_TOPGEN], 1u);
            else XB_SPIN(xb_ld(&bar[XB_TOPGEN]) == tg, bar);
            __builtin_amdgcn_fence(__ATOMIC_ACQUIRE, "agent");
            xb_add(&bar[XB_XGEN(b.x)], 1u);
            asm volatile("s_waitcnt vmcnt(0)" ::: "memory");
        } else {
            XB_SPIN(xb_ld(&bar[XB_XGEN(b.x)]) == gen, bar);
            __builtin_amdgcn_fence(__ATOMIC_ACQUIRE, "agent");
            asm volatile("s_waitcnt vmcnt(0)" ::: "memory");
        }
    }
    __syncthreads();
}

struct Args { const float* in[10]; float* out; unsigned char* ws; int ph_lo, ph_hi; };

__device__ __forceinline__ void p0_transpose_item(const float* W, int K, int N, bf16* WT, LAS float* scr, int item, int lane) {
    const int nblk = N / 32, kb = item / nblk, nb = item % nblk, k0 = 64 * kb, n0 = 32 * nb;
    { float tv[32];
#pragma unroll
      for (int i = 0; i < 32; ++i) { const int kk = 2 * i + (lane >> 5); tv[i] = W[(size_t)(k0 + kk) * N + n0 + (lane & 31)]; }
      asm volatile("" ::: "memory");
#pragma unroll
      for (int i = 0; i < 32; ++i) { const int kk = 2 * i + (lane >> 5); scr[kk * 33 + (lane & 31)] = tv[i]; } }
    LDS_WAIT();
    const int c = lane & 7;
#pragma unroll
    for (int j = 0; j < 4; ++j) { const int n = (lane >> 3) + 8 * j; const LAS float* s = scr + (8 * c) * 33 + n;
        v4u o; o.x = pk2(s[0 * 33], s[1 * 33]); o.y = pk2(s[2 * 33], s[3 * 33]); o.z = pk2(s[4 * 33], s[5 * 33]); o.w = pk2(s[6 * 33], s[7 * 33]);
        *(v4u*)(WT + (size_t)(n0 + n) * K + k0 + 8 * c) = o; }
    LDS_WAIT();
}
__device__ __forceinline__ void p0_fold_item(const float* w_in, const float* w_pool, bf16* Win_t, LAS unsigned char* lds, int item, int tid) {
    const int g = item & 3, k0 = (item >> 2) * 16;
    LAS float* As = (LAS float*)lds;
    LAS float* Bs = (LAS float*)(lds + 8192);
    { f32x4 av, bv[8];
      { const int r = tid >> 5, c4 = tid & 31; av = *(const f32x4*)(w_in + (size_t)(k0 + r) * NIN + g * 128 + c4 * 4); }
#pragma unroll
      for (int i = 0; i < 8; ++i) { const int e = tid + i * NTHREADS, r = e >> 5, c4 = e & 31; bv[i] = *(const f32x4*)(w_pool + (size_t)g * 16384 + (size_t)r * 128 + c4 * 4); }
      { const int r = tid >> 5, c4 = tid & 31; *(LAS f32x4*)(As + r * 128 + c4 * 4) = av; }
#pragma unroll
      for (int i = 0; i < 8; ++i) { const int e = tid + i * NTHREADS, r = e >> 5, c4 = e & 31; *(LAS f32x4*)(Bs + r * 128 + c4 * 4) = bv[i]; } }
    __syncthreads();
    const int n = tid & 127, kq = tid >> 7;
    float acc[4] = {0.f, 0.f, 0.f, 0.f};
#pragma unroll 4
    for (int c = 0; c < 128; c += 4) {
        const float b0 = Bs[(c + 0) * 128 + n], b1 = Bs[(c + 1) * 128 + n], b2 = Bs[(c + 2) * 128 + n], b3 = Bs[(c + 3) * 128 + n];
#pragma unroll
        for (int i = 0; i < 4; ++i) { const f32x4 a = *(const LAS f32x4*)(As + (kq * 4 + i) * 128 + c); acc[i] += (a[0] * b0 + a[1] * b1) + (a[2] * b2 + a[3] * b3); }
    }
    v2u o; o.x = pk2(acc[0], acc[1]); o.y = pk2(acc[2], acc[3]);
    *(v2u*)(Win_t + (size_t)(g * 128 + n) * D + k0 + kq * 4) = o;
    __syncthreads();
}

__device__ __forceinline__ void p0_adaln_item(const float* c, const float* w_ada, const float* b_ada, float* mod, LAS unsigned char* lds, int item, int tid) {
    const int lane = tid & 63, wave = tid >> 6;
    const int jb = item >> 2, bg = item & 3, j0 = jb * 64, b0 = bg * 8;
    LAS float* sT = (LAS float*)lds;
    LAS float* part = (LAS float*)(lds + 32768);
    { float cv[16];
#pragma unroll
      for (int i = 0; i < 16; ++i) { const int e = tid + i * NTHREADS; cv[i] = c[(size_t)(b0 + (e >> 10)) * D + (e & 1023)]; }
#pragma unroll
      for (int i = 0; i < 16; ++i) { const int e = tid + i * NTHREADS, b = e >> 10, k = e & 1023; const float v = cv[i]; sT[k * 8 + b] = v * __builtin_amdgcn_rcpf(1.0f + __expf(-v)); } }
    __syncthreads();
    const int cg = lane & 15, ks = lane >> 4;
    f32x4 acc[8];
#pragma unroll
    for (int i = 0; i < 8; ++i) acc[i] = (f32x4){0.f, 0.f, 0.f, 0.f};
    const float* wp = w_ada + (size_t)(wave * 128 + ks) * NIN + j0 + 4 * cg;
#pragma unroll 1
    for (int i0_ = 0; i0_ < 32; i0_ += 16) {
        f32x4 wv[16];
#pragma unroll
        for (int j = 0; j < 16; ++j) wv[j] = *(const f32x4*)(wp + (size_t)(4 * (i0_ + j)) * NIN);
        asm volatile("" ::: "memory");
#pragma unroll
        for (int j = 0; j < 16; ++j) {
            const int k = wave * 128 + 4 * (i0_ + j) + ks;
            const f32x4 s0 = *(const LAS f32x4*)(sT + k * 8), s1 = *(const LAS f32x4*)(sT + k * 8 + 4);
            acc[0] += wv[j] * s0[0]; acc[1] += wv[j] * s0[1]; acc[2] += wv[j] * s0[2]; acc[3] += wv[j] * s0[3];
            acc[4] += wv[j] * s1[0]; acc[5] += wv[j] * s1[1]; acc[6] += wv[j] * s1[2]; acc[7] += wv[j] * s1[3];
        }
    }
#pragma unroll
    for (int i = 0; i < 8; ++i) *(LAS f32x4*)(part + ((wave * 4 + ks) * 8 + i) * 64 + 4 * cg) = acc[i];
    __syncthreads();
    { const int b = tid >> 6; float s = b_ada[j0 + lane];
#pragma unroll 8
      for (int w = 0; w < 32; ++w) s += part[(w * 8 + b) * 64 + lane];
      mod[(size_t)(b0 + b) * NIN + j0 + lane] = s; }
    __syncthreads();
}

__device__ __forceinline__ void p1_rows(const float* x, const float* g_pre, const float* mod, bf16* H, int gw, int ngw, int lane) {
    constexpr int RPW = 32, PF = 4;
    for (int it = gw; it < M / RPW; it += ngw) {
        const int row0 = it * RPW, b = row0 / SEQ;
        f32x4 gm[4], sh[4];
#pragma unroll
        for (int j = 0; j < 4; ++j) { const int k = 8 * lane + 512 * (j >> 1) + 4 * (j & 1);
            const f32x4 g = *(const f32x4*)(g_pre + k), sc = *(const f32x4*)(mod + (size_t)b * NIN + 1024 + k);
            gm[j] = g * (sc + 1.0f); sh[j] = *(const f32x4*)(mod + (size_t)b * NIN + k); }
        const float* xb = x + (size_t)row0 * D + 8 * lane;
        bf16* ob = H + (size_t)row0 * D + 8 * lane;
        f32x4 buf[PF][4];
#pragma unroll
        for (int p = 0; p < PF; ++p)
#pragma unroll
            for (int j = 0; j < 4; ++j) buf[p][j] = __builtin_nontemporal_load((const f32x4*)(xb + (size_t)p * D + 512 * (j >> 1) + 4 * (j & 1)));
#pragma unroll 1
        for (int r = 0; r < RPW; r += PF) {
#pragma unroll
            for (int p = 0; p < PF; ++p) {
                f32x4 v[4]; float s = 0.f;
#pragma unroll
                for (int j = 0; j < 4; ++j) { v[j] = buf[p][j]; s += (v[j][0] * v[j][0] + v[j][1] * v[j][1]) + (v[j][2] * v[j][2] + v[j][3] * v[j][3]); }
                { const int rn = (r + p + PF < RPW) ? (r + p + PF) : (RPW - 1);
#pragma unroll
                    for (int j = 0; j < 4; ++j) buf[p][j] = __builtin_nontemporal_load((const f32x4*)(xb + (size_t)rn * D + 512 * (j >> 1) + 4 * (j & 1))); }
                const float rstd = 1.0f / sqrtf(wave_sum(s) * (1.0f / D) + EPS);
                bf16* op = ob + (size_t)(r + p) * D;
#pragma unroll
                for (int j = 0; j < 2; ++j) { const f32x4 h0 = (v[2 * j] * rstd) * gm[2 * j] + sh[2 * j], h1 = (v[2 * j + 1] * rstd) * gm[2 * j + 1] + sh[2 * j + 1];
                    v4u o; o.x = pk2(h0[0], h0[1]); o.y = pk2(h0[2], h0[3]); o.z = pk2(h1[0], h1[1]); o.w = pk2(h1[2], h1[3]); *(v4u*)(op + 512 * j) = o; }
            }
        }
    }
}

__device__ __forceinline__ void add8(float (&a)[8], const v4u c) {
    a[0] += bflo(c.x); a[1] += bfhi(c.x); a[2] += bflo(c.y); a[3] += bfhi(c.y); a[4] += bflo(c.z); a[5] += bfhi(c.z); a[6] += bflo(c.w); a[7] += bfhi(c.w);
}
__device__ __forceinline__ void unpack8(float (&f)[8], const v4u c) { f[0] = bflo(c.x); f[1] = bfhi(c.x); f[2] = bflo(c.y); f[3] = bfhi(c.y); f[4] = bflo(c.z); f[5] = bfhi(c.z); f[6] = bflo(c.w); f[7] = bfhi(c.w); }
template <int W> __device__ __forceinline__ void pool_item(const bf16* P, const float* pool_scale, bf16* Y, int tt, int gi, int lane) {
    const int c16 = lane & 15, tg = lane >> 4;
    const int row0 = tt * 32 + tg * 8, tf = row0 & (SEQ - 1);
    const size_t prow = ((size_t)((row0 >> 11) * 4 + gi) * SEQ + tf) * 128 + c16 * 8;
    const bf16* up = P + B_U + prow; const bf16* gp = P + B_GP + prow;
    asm volatile("" : "+v"(up), "+v"(gp));
    v4u u[W + 7], g[8];
#pragma unroll
    for (int r = 0; r < W + 7; ++r) { const int dr = r - (W - 1); const bool ok = (tf + dr >= 0); u[r] = *(const v4u*)(up + (ptrdiff_t)(ok ? dr : 0) * 128); if (!ok) u[r] = (v4u){0u, 0u, 0u, 0u}; }
#pragma unroll
    for (int i = 0; i < 8; ++i) g[i] = *(const v4u*)(gp + (size_t)i * 128);
    const f32x4 ps0 = *(const f32x4*)(pool_scale + gi * 128 + c16 * 8), ps1 = *(const f32x4*)(pool_scale + gi * 128 + c16 * 8 + 4);
    const float ps[8] = {ps0[0], ps0[1], ps0[2], ps0[3], ps1[0], ps1[1], ps1[2], ps1[3]};
    float S[8];
#pragma unroll
    for (int e = 0; e < 8; ++e) S[e] = 0.f;
#pragma unroll
    for (int r = 0; r < W - 1; ++r) { float f[8]; unpack8(f, u[r]);
#pragma unroll
        for (int e = 0; e < 8; ++e) S[e] += f[e]; }
    bf16* yp = Y + (size_t)row0 * D + gi * 128 + c16 * 8;
#pragma unroll
    for (int i = 0; i < 8; ++i) {
        float own[8], gv[8]; unpack8(own, u[W - 1 + i]); unpack8(gv, g[i]);
#pragma unroll
        for (int e = 0; e < 8; ++e) S[e] += own[e];
        const int t = tf + i; const float inv = 1.0f / (float)((t + 1 < W) ? (t + 1) : W);
        float y[8];
#pragma unroll
        for (int e = 0; e < 8; ++e) y[e] = (S[e] * inv - own[e]) * ps[e] * silu_f(gv[e]);
        v4u o; o.x = pk2(y[0], y[1]); o.y = pk2(y[2], y[3]); o.z = pk2(y[4], y[5]); o.w = pk2(y[6], y[7]);
        *(v4u*)(yp + (size_t)i * D) = o;
        float old[8]; unpack8(old, u[i]);
#pragma unroll
        for (int e = 0; e < 8; ++e) S[e] -= old[e];
    }
}

__device__ __forceinline__ s16x4 vtr(LAS const unsigned char* p) { return __builtin_bit_cast(s16x4, __builtin_amdgcn_ds_read_tr16_b64_v4i16((LAS s16x4*)p)); }
template <bool DIAG> __device__ __forceinline__ void attn_tile(const bf16x8 (&qf)[4], bf16x8 (&kf)[4], v4u (&vv)[4], const bf16* kb, const bf16* vb, int kn, bool more,
                                                            LAS unsigned char* vw, const LAS unsigned char* vr, f32x16& o0, f32x16& o1, float& carry, int r32, int hi) {
    f32x16 p;
#pragma unroll
    for (int r = 0; r < 16; ++r) p[r] = 0.f;
#pragma unroll
    for (int d0 = 0; d0 < 4; ++d0) p = __builtin_amdgcn_mfma_f32_32x32x16_bf16(kf[d0], qf[d0], p, 0, 0, 0);
    LDS_WAIT();
#pragma unroll
    for (int i = 0; i < 4; ++i) *(LAS v4u*)(vw + 8 * i * 64) = vv[i];
    if (more) {
#pragma unroll
        for (int d0 = 0; d0 < 4; ++d0) kf[d0] = *(const bf16x8*)(kb + (size_t)kn * HD + 16 * d0);
#pragma unroll
        for (int i = 0; i < 4; ++i) vv[i] = *(const v4u*)(vb + (size_t)(kn + 8 * i) * HD); }
    float w[16], bt[16];
#pragma unroll
    for (int r = 0; r < 16; ++r) {
        const float e = __builtin_amdgcn_exp2f(__builtin_fminf(p[r], 126.0f));
        const float wi = __builtin_amdgcn_rcpf(1.0f + e);
        if (DIAG) { const bool valid = ((r & 3) + 8 * (r >> 2) + 4 * hi) < r32; w[r] = valid ? wi : 1.0f; bt[r] = valid ? e * wi : 0.f; }
        else { w[r] = wi; bt[r] = e * wi; }
    }
    float pr[4], up_[4];
#pragma unroll
    for (int m = 0; m < 4; ++m) { const float gsm = (w[4 * m] * w[4 * m + 1]) * (w[4 * m + 2] * w[4 * m + 3]);
        float ga = gsm, gb = gsm;
        asm volatile("s_nop 1\n\tv_permlane32_swap_b32 %0, %1\n\ts_nop 1" : "+v"(ga), "+v"(gb));
        pr[m] = ga * gb; up_[m] = gb; }
    float T[4]; T[3] = 1.0f; T[2] = pr[3]; T[1] = T[2] * pr[2]; T[0] = T[1] * pr[1];
    const float total = T[0] * pr[0];
    float a[16];
#pragma unroll
    for (int m = 0; m < 4; ++m) {
        const float base = (carry * T[m]) * (hi == 0 ? up_[m] : 1.0f);
        const float t3 = base, t2 = t3 * w[4 * m + 3], t1 = t2 * w[4 * m + 2], t0 = t1 * w[4 * m + 1];
        a[4 * m + 3] = bt[4 * m + 3] * t3; a[4 * m + 2] = bt[4 * m + 2] * t2; a[4 * m + 1] = bt[4 * m + 1] * t1; a[4 * m + 0] = bt[4 * m + 0] * t0;
    }
    carry *= total;
    v4u pw0, pw1;
    pw0.x = pk2(a[0], a[1]); pw0.y = pk2(a[2], a[3]); pw0.z = pk2(a[4], a[5]); pw0.w = pk2(a[6], a[7]);
    pw1.x = pk2(a[8], a[9]); pw1.y = pk2(a[10], a[11]); pw1.z = pk2(a[12], a[13]); pw1.w = pk2(a[14], a[15]);
    const bf16x8 pf0 = __builtin_bit_cast(bf16x8, pw0), pf1 = __builtin_bit_cast(bf16x8, pw1);
    LDS_WAIT();
    {
        const s16x4 a00 = vtr(vr + 0), a01 = vtr(vr + 512), a10 = vtr(vr + 1024), a11 = vtr(vr + 1536);
        const s16x4 b00 = vtr(vr + 2048), b01 = vtr(vr + 2048 + 512), b10 = vtr(vr + 2048 + 1024), b11 = vtr(vr + 2048 + 1536);
        const bf16x8 va0 = (bf16x8){a00[0], a00[1], a00[2], a00[3], a01[0], a01[1], a01[2], a01[3]};
        const bf16x8 va1 = (bf16x8){a10[0], a10[1], a10[2], a10[3], a11[0], a11[1], a11[2], a11[3]};
        const bf16x8 vb0 = (bf16x8){b00[0], b00[1], b00[2], b00[3], b01[0], b01[1], b01[2], b01[3]};
        const bf16x8 vb1 = (bf16x8){b10[0], b10[1], b10[2], b10[3], b11[0], b11[1], b11[2], b11[3]};
        o0 = __builtin_amdgcn_mfma_f32_32x32x16_bf16(va0, pf0, o0, 0, 0, 0);
        o0 = __builtin_amdgcn_mfma_f32_32x32x16_bf16(va1, pf1, o0, 0, 0, 0);
        o1 = __builtin_amdgcn_mfma_f32_32x32x16_bf16(vb0, pf0, o1, 0, 0, 0);
        o1 = __builtin_amdgcn_mfma_f32_32x32x16_bf16(vb1, pf1, o1, 0, 0, 0);
    }
    asm volatile("" ::: "memory");
}
__device__ __forceinline__ void swap_halves(unsigned& a, unsigned& b) { asm volatile("s_nop 1\n\tv_permlane32_swap_b32 %0, %1\n\ts_nop 1" : "+v"(a), "+v"(b)); }
__device__ __forceinline__ void load_gates(v4u (&g)[4], const bf16* p) {
#pragma unroll
    for (int j = 0; j < 4; ++j) g[j] = *(const v4u*)(p + 16 * j);
}
__device__ __forceinline__ void unswap_gates(v2u (&g)[8], const v4u (&L)[4]) {
#pragma unroll
    for (int j = 0; j < 4; ++j) { unsigned l0 = L[j].x, l1 = L[j].y, l2 = L[j].z, l3 = L[j].w; swap_halves(l0, l2); swap_halves(l1, l3); g[2 * j] = (v2u){l0, l1}; g[2 * j + 1] = (v2u){l2, l3}; }
}
__device__ __forceinline__ void attn_phase(const bf16* P, bf16* Y, LAS unsigned char* vl, int vgw, int ngw, int lane) {
    const int r32 = lane & 31, hi = lane >> 5;
    LAS unsigned char* vw = vl + ((lane & 7) >> 2) * 2048 + (lane >> 3) * 64 + (lane & 3) * 16;
    const LAS unsigned char* vr = vl + (4 * hi + ((lane & 15) >> 2)) * 64 + ((lane >> 4) & 1) * 32 + (lane & 3) * 8;
    constexpr int NITEM = BATCH * NH * (SEQ / 32);
    if (vgw >= NITEM) return;
    const size_t qoff = (size_t)r32 * HD + 8 * hi;
    bf16x8 qn[4]; v4u gn[4];
    { const int it = vgw, qt = it & 63; const size_t hb = (size_t)(it >> 6) * SEQ * HD + (size_t)qt * 32 * HD + qoff;
#pragma unroll
      for (int d0 = 0; d0 < 4; ++d0) qn[d0] = *(const bf16x8*)(P + B_Q + hb + 16 * d0);
      load_gates(gn, P + B_GS + hb); }
#pragma unroll 1
    for (int it = vgw; it < NITEM; it += ngw) {
        const int qt = it & 63, bh = it >> 6, b = bh >> 3, h = bh & 7, q0 = qt * 32;
        const size_t rowbase = (size_t)b * SEQ, hb = (size_t)bh * SEQ * HD;
        const bf16* kb = P + B_K + hb + qoff;
        const bf16* vb = P + B_V + hb + (size_t)lane * 8;
        bf16x8 qf[4], kf[4]; v4u vv[4]; v4u gr[4]; unsigned touch;
#pragma unroll
        for (int d0 = 0; d0 < 4; ++d0) { qf[d0] = qn[d0]; kf[d0] = *(const bf16x8*)(kb + (size_t)q0 * HD + 16 * d0); }
#pragma unroll
        for (int i = 0; i < 4; ++i) vv[i] = *(const v4u*)(vb + (size_t)(q0 + 8 * i) * HD);
#pragma unroll
        for (int e = 0; e < 4; ++e) gr[e] = gn[e];
        f32x16 o0, o1;
#pragma unroll
        for (int r = 0; r < 16; ++r) { o0[r] = 0.f; o1[r] = 0.f; }
        float carry = 1.0f;
        attn_tile<true>(qf, kf, vv, kb, vb, q0 - 32, qt > 0, vw, vr, o0, o1, carry, r32, hi);
        { const int itn = (it + ngw < NITEM) ? it + ngw : it;
          const size_t hbn = (size_t)(itn >> 6) * SEQ * HD + (size_t)(itn & 63) * 32 * HD + qoff;
#pragma unroll
          for (int d0 = 0; d0 < 4; ++d0) qn[d0] = *(const bf16x8*)(P + B_Q + hbn + 16 * d0);
          load_gates(gn, P + B_GS + hbn);
          touch = *(const unsigned*)(P + (hi ? B_V : B_K) + (size_t)(itn >> 6) * SEQ * HD + (size_t)((itn & 63) * 32 + r32) * HD); }
#pragma unroll 1
        for (int kt = qt - 1; kt >= 0; --kt) {
            if (__all(carry == 0.f)) break;
            attn_tile<false>(qf, kf, vv, kb, vb, (kt - 1) * 32, kt > 0, vw, vr, o0, o1, carry, r32, hi);
        }
        bf16* yp = Y + (rowbase + q0 + r32) * D + 512 + h * HD + 8 * hi;
        v2u yw[8], gv[8];
        unswap_gates(gv, gr);
#pragma unroll
        for (int dt = 0; dt < 2; ++dt)
#pragma unroll
            for (int m = 0; m < 4; ++m) {
                const v2u g = gv[4 * dt + m];
                const f32x16& o = dt ? o1 : o0;
                const float y0 = o[4 * m + 0] * silu_f(bflo(g.x)), y1 = o[4 * m + 1] * silu_f(bfhi(g.x));
                const float y2 = o[4 * m + 2] * silu_f(bflo(g.y)), y3 = o[4 * m + 3] * silu_f(bfhi(g.y));
                yw[4 * dt + m].x = pk2(y0, y1); yw[4 * dt + m].y = pk2(y2, y3); }
#pragma unroll
        for (int j = 0; j < 4; ++j) { unsigned a0 = yw[2 * j].x, a1 = yw[2 * j].y, b0 = yw[2 * j + 1].x, b1 = yw[2 * j + 1].y; swap_halves(a0, b0); swap_halves(a1, b1);
            *(v4u*)(yp + 16 * j) = (v4u){a0, a1, b0, b1}; }
        asm volatile("" :: "v"(touch));
    }
}

__device__ __forceinline__ void p5_rows(const float* x, const float* g_post, const float* mod, const bf16* Yo, const float* ssq, float* out, int gw, int ngw, int lane) {
    constexpr int RPW = 32, PF = 4;
    for (int it = gw; it < M / RPW; it += ngw) {
        const int row0 = it * RPW, b = row0 / SEQ;
        f32x4 gg[4];
#pragma unroll
        for (int j = 0; j < 2; ++j)
#pragma unroll
            for (int e = 0; e < 2; ++e) { const int k = 8 * lane + 512 * j + 4 * e; gg[2 * j + e] = *(const f32x4*)(g_post + k) * *(const f32x4*)(mod + (size_t)b * NIN + 2048 + k); }
        float rstd_l;
        { const f32x4* sq = (const f32x4*)(ssq + (size_t)(row0 + (lane & 31)) * 16);
          const f32x4 s0 = sq[0], s1 = sq[1], s2 = sq[2], s3 = sq[3];
          const float ss = ((s0[0] + s0[1]) + (s0[2] + s0[3])) + ((s1[0] + s1[1]) + (s1[2] + s1[3])) + ((s2[0] + s2[1]) + (s2[2] + s2[3])) + ((s3[0] + s3[1]) + (s3[2] + s3[3]));
          rstd_l = 1.0f / sqrtf(ss * (1.0f / D) + EPS); }
        const float* xb = x + (size_t)row0 * D + 8 * lane;
        const bf16* yb = Yo + (size_t)row0 * D + 8 * lane;
        float* ob = out + (size_t)row0 * D + 8 * lane;
        v4u ybuf[PF][2]; f32x4 xbuf[PF][4];
#pragma unroll
        for (int p = 0; p < PF; ++p)
#pragma unroll
            for (int j = 0; j < 2; ++j) { ybuf[p][j] = __builtin_nontemporal_load((const v4u*)(yb + (size_t)p * D + 512 * j));
                xbuf[p][2 * j] = __builtin_nontemporal_load((const f32x4*)(xb + (size_t)p * D + 512 * j)); xbuf[p][2 * j + 1] = __builtin_nontemporal_load((const f32x4*)(xb + (size_t)p * D + 512 * j + 4)); }
#pragma unroll 1
        for (int r = 0; r < RPW; r += PF) {
#pragma unroll
            for (int p = 0; p < PF; ++p) {
                v4u y[2]; f32x4 xv[4];
#pragma unroll
                for (int j = 0; j < 2; ++j) { y[j] = ybuf[p][j]; xv[2 * j] = xbuf[p][2 * j]; xv[2 * j + 1] = xbuf[p][2 * j + 1]; }
                { const size_t ro = (size_t)((r + p + PF < RPW) ? (r + p + PF) : (RPW - 1)) * D;
#pragma unroll
                    for (int j = 0; j < 2; ++j) { ybuf[p][j] = __builtin_nontemporal_load((const v4u*)(yb + ro + 512 * j));
                        xbuf[p][2 * j] = __builtin_nontemporal_load((const f32x4*)(xb + ro + 512 * j)); xbuf[p][2 * j + 1] = __builtin_nontemporal_load((const f32x4*)(xb + ro + 512 * j + 4)); } }
                const float rstd = __builtin_bit_cast(float, __builtin_amdgcn_readlane(__builtin_bit_cast(int, rstd_l), r + p));
                float* op = ob + (size_t)(r + p) * D;
#pragma unroll
                for (int j = 0; j < 2; ++j) {
                    const f32x4 y0 = {bflo(y[j].x), bfhi(y[j].x), bflo(y[j].y), bfhi(y[j].y)}, y1 = {bflo(y[j].z), bfhi(y[j].z), bflo(y[j].w), bfhi(y[j].w)};
                    __builtin_nontemporal_store(xv[2 * j] + gg[2 * j] * (y0 * rstd), (f32x4*)(op + 512 * j));
                    __builtin_nontemporal_store(xv[2 * j + 1] + gg[2 * j + 1] * (y1 * rstd), (f32x4*)(op + 512 * j + 4)); }
            }
        }
    }
}

__global__ void __launch_bounds__(NTHREADS, 2) fwd_kernel(Args args) {
    extern __shared__ __attribute__((aligned(16))) unsigned char lds_raw[];
    LAS unsigned char* lds = (LAS unsigned char*)lds_raw;
    const int tid = threadIdx.x, lane = tid & 63, wave = __builtin_amdgcn_readfirstlane(tid >> 6);
    const int G = gridDim.x, gw = blockIdx.x * NWAVES + wave, ngw = G * NWAVES;
    unsigned char* ws = args.ws;
    const float* x = args.in[0]; const float* c = args.in[1]; const float* w_ada = args.in[2]; const float* b_ada = args.in[3]; const float* g_pre = args.in[4];
    const float* w_in = args.in[5]; const float* w_pool = args.in[6]; const float* pool_scale = args.in[7]; const float* w_out = args.in[8]; const float* g_post = args.in[9];
    float* mod = (float*)(ws + WS_MOD); bf16* Win_t = (bf16*)(ws + WS_WIN); bf16* Wout_t = (bf16*)(ws + WS_WOUT);
    float* ssq = (float*)(ws + WS_SSQ); bf16* H = (bf16*)(ws + WS_H); bf16* Y = (bf16*)(ws + WS_H); bf16* P = (bf16*)(ws + WS_P); bf16* Yo = (bf16*)(ws + WS_YO);
    const int lo = args.ph_lo, hi_ = args.ph_hi;
    if (tid < 2) ((volatile LAS unsigned*)(lds + LDS_BARST))[tid] = 0u;
    __syncthreads();
    XcdBarrier xbar; xbar.bar = (unsigned*)(ws + WS_BAR); xbar.x = 0; xbar.st = (volatile LAS unsigned*)(lds + LDS_BARST);
#define IN(k) (lo <= (k) && (k) < hi_)
#define SEAM(k) do { if (IN(k) && IN((k) + 1)) { if ((k) == 0) { cg::this_grid().sync(); xbar = xcd_barrier_post((unsigned*)(ws + WS_BAR), (volatile LAS unsigned*)(lds + LDS_BARST)); } else xcd_barrier(xbar); } } while (0)

    if (IN(0)) {
        if (blockIdx.x == 0) for (int i = tid; i < XCD_BAR_WORDS; i += NTHREADS) ((unsigned*)(ws + WS_BAR))[i] = 0u;
        for (int it = blockIdx.x; it < 192; it += G) p0_adaln_item(c, w_ada, b_ada, mod, lds, it, tid);
    }
    SEAM(0);
    if (IN(1)) p1_rows(x, g_pre, mod, H, gw, ngw, lane);
    if (IN(1)) {
        for (int it = blockIdx.x; it < 4 * (D / 16); it += G) p0_fold_item(w_in, w_pool, Win_t, lds, it, tid);
        LAS float* scr = (LAS float*)(lds + wave * 16384);
        constexpr int NB_IN = (NIN - 512) / 32, I_IN = (D / 64) * NB_IN, I_OUT = (D / 64) * (D / 32);
        for (int it = gw; it < I_IN + I_OUT; it += ngw) {
            int r = it;
            if (r < I_IN) { const int kb = r / NB_IN, nb = 16 + r % NB_IN; p0_transpose_item(w_in, D, NIN, Win_t, scr, kb * (NIN / 32) + nb, lane); continue; } r -= I_IN;
            p0_transpose_item(w_out, D, D, Wout_t, scr, r, lane);
        }
    }
    SEAM(1);
    if (IN(2)) {
        pg8::Gemm g{H, Win_t, M, NIN, D}; pg8::StaticOrder S; S.init(M, NIN, G, (int)blockIdx.x, WGM_IN);
        pg8::EpiP E{P};
        pg8::gemm_phase<pg8::EpiP, pg8::StaticOrder, true, true>(lds, g, S, E);
    }
    SEAM(2);
    if (IN(3)) {
        LAS unsigned char* vl = lds + wave * 16384;
#define POOL_ALL() for (int it = gw; it < (M / 32) * 4; it += ngw) { const int tt = it & (M / 32 - 1), gi = (tt + (it >> 11)) & 3; \
                    if (gi == 0) pool_item<2>(P, pool_scale, Y, tt, 0, lane); else if (gi == 1) pool_item<4>(P, pool_scale, Y, tt, 1, lane); \
                    else if (gi == 2) pool_item<8>(P, pool_scale, Y, tt, 2, lane); else pool_item<16>(P, pool_scale, Y, tt, 3, lane); }
        const int vgw = ((G % 8 == 0) ? ((int)blockIdx.x % 8) * (G / 8) + (int)blockIdx.x / 8 : (int)blockIdx.x) * NWAVES + wave;
        if (wave < 4) { attn_phase(P, Y, vl, vgw, ngw, lane); POOL_ALL(); }
        else { POOL_ALL(); attn_phase(P, Y, vl, vgw, ngw, lane); }
#undef POOL_ALL
    }
    SEAM(3);
    if (IN(4)) {
        pg8::Gemm g{Y, Wout_t, M, D, D}; pg8::StaticOrder S; S.init(M, D, G, (int)blockIdx.x, WGM_OUT);
        pg8::EpiY E{Yo, D, ssq};
        pg8::gemm_phase<pg8::EpiY, pg8::StaticOrder, true, true>(lds, g, S, E);
    }
    SEAM(4);
    if (IN(5)) p5_rows(x, g_post, mod, Yo, ssq, args.out, gw, ngw, lane);

#undef IN
#undef SEAM
}

#ifndef MK_N_LAUNCHES
#define MK_N_LAUNCHES 1
#endif
extern "C" void kernel_launch(void* const* d_in, const int* in_sizes, int n_in, void* d_out, int out_size, void* d_ws, size_t ws_size, hipStream_t stream) {
    static int grid = 0;
    if (grid == 0) {
        if (n_in != 10 || in_sizes[0] != M * D || out_size != M * D || ws_size < WS_END) { fprintf(stderr, "kernel_launch: unexpected shapes (n_in %d, in0 %d, out %d, ws %zu); nothing launched\n", n_in, n_in > 0 ? in_sizes[0] : -1, out_size, ws_size); grid = -1; return; }
        int dev = 0, cus = 0, per_cu = 0;
        if (hipGetDevice(&dev) != hipSuccess || hipDeviceGetAttribute(&cus, hipDeviceAttributeMultiprocessorCount, dev) != hipSuccess) { grid = -1; return; }
        if (hipFuncSetAttribute((const void*)fwd_kernel, hipFuncAttributeMaxDynamicSharedMemorySize, LDS_BYTES) != hipSuccess) { fprintf(stderr, "kernel_launch: hipFuncSetAttribute failed\n"); grid = -1; return; }
        if (hipOccupancyMaxActiveBlocksPerMultiprocessor(&per_cu, (const void*)fwd_kernel, NTHREADS, LDS_BYTES) != hipSuccess || per_cu < 1) { fprintf(stderr, "kernel_launch: occupancy query says %d blocks per CU\n", per_cu); per_cu = 1; }
        (void)hipGetLastError();
        grid = cus * 1;
    }
    if (grid < 0) return;
    Args a{};
    for (int i = 0; i < 10; ++i) a.in[i] = (const float*)d_in[i];
    a.out = (float*)d_out; a.ws = (unsigned char*)d_ws;
#if MK_N_LAUNCHES == 1
    a.ph_lo = 0; a.ph_hi = 6;
    void* kargs[] = {&a};
    hipError_t e = hipLaunchCooperativeKernel((const void*)fwd_kernel, dim3(grid), dim3(NTHREADS), kargs, LDS_BYTES, stream);
    if (e != hipSuccess) fprintf(stderr, "kernel_launch: cooperative launch failed: %s (grid %d)\n", hipGetErrorString(e), grid);
#else
    for (int ph = 0; ph < 6; ++ph) { a.ph_lo = ph; a.ph_hi = ph + 1; hipLaunchKernelGGL(fwd_kernel, dim3(grid), dim3(NTHREADS), LDS_BYTES, stream, a); }
#endif
}
```
